# Optimizing an MI355X kernel written in HIP

```python
import math
import jax, jax.numpy as jnp
from jax import lax
import numpy as np

D_MODEL = 1024
BATCH = 4
SEQ = 8192
DEPTH = 2

HEAD_DIM = 64
D_MIX = 2 * D_MODEL
A_WIDTH = 3 * D_MIX // 8
B_WIDTH = 3 * D_MIX // 8
C_WIDTH = D_MIX // 4
A_Q_HEADS = A_WIDTH // HEAD_DIM
A_KV_HEADS = A_Q_HEADS // 4
A_WINDOW = 128
B_HEADS = B_WIDTH // HEAD_DIM
B_PATTERNS = ((128, 1), (512, 4), (2048, 16))
C_V_DIM = 2 * HEAD_DIM
C_HEADS = C_WIDTH // C_V_DIM
N_BIAS_HEADS = A_Q_HEADS + B_HEADS + C_HEADS
REL_BUCKETS = 32
REL_MAX_DIST = 2048
BLK = 128
EPS = 1e-6
NEG = -1e30
PROJ_SIZES = (A_Q_HEADS * HEAD_DIM, A_KV_HEADS * HEAD_DIM, A_KV_HEADS * HEAD_DIM,
              B_WIDTH, B_WIDTH, B_WIDTH,
              2 * C_HEADS * HEAD_DIM, 2 * C_HEADS * HEAD_DIM, C_HEADS * C_V_DIM,
              D_MIX)
PROJ_OUT = sum(PROJ_SIZES)

kernel_name = "hybrid_swa_dilated_diff_attn_block"


def rms_norm(x, g):
    xf = x.astype(jnp.float32)
    y = xf * lax.rsqrt(jnp.mean(xf * xf, axis=-1, keepdims=True) + EPS)
    return (y * g.astype(jnp.float32)).astype(x.dtype)


def rel_bucket(dist):
    n = jnp.maximum(dist, 0)
    max_exact = REL_BUCKETS // 2
    nf = jnp.maximum(n, 1).astype(jnp.float32)
    large = max_exact + (jnp.log(nf / max_exact) / math.log(REL_MAX_DIST / max_exact)
                         * (REL_BUCKETS - max_exact)).astype(jnp.int32)
    large = jnp.minimum(large, REL_BUCKETS - 1)
    return jnp.where(n < max_exact, n, large)


def banded_attention(q, k, v, table_h, max_dist, dist_scale, sink=None):
    Bn, L, Hq, dh = q.shape
    Hkv = k.shape[2]
    G = Hq // Hkv
    nb = L // BLK
    dist = jnp.arange(BLK)[:, None] + BLK - jnp.arange(2 * BLK)[None, :]
    valid = (jnp.arange(nb)[:, None] * BLK - BLK + jnp.arange(2 * BLK)[None, :]) >= 0
    allowed = ((dist >= 0) & (dist <= max_dist))[None] & valid[:, None, :]
    bias = table_h[rel_bucket(dist * dist_scale)].astype(jnp.float32)
    bias = bias.transpose(2, 0, 1).reshape(Hkv, G, BLK, 2 * BLK)

    def key_blocks(t):
        tp = jnp.pad(t, ((0, 0), (BLK, 0), (0, 0), (0, 0)))
        prev = tp[:, :L].reshape(Bn, nb, BLK, Hkv, dh)
        cur = t.reshape(Bn, nb, BLK, Hkv, dh)
        return jnp.concatenate([prev, cur], axis=2)

    kb, vb = key_blocks(k), key_blocks(v)
    qb = q.reshape(Bn, nb, BLK, Hkv, G, dh)
    s = jnp.einsum('bnqhgd,bnkhd->bnhgqk', qb, kb,
                   preferred_element_type=jnp.float32) * (1.0 / math.sqrt(dh))
    s = s + bias[None, None]
    s = jnp.where(allowed[None, :, None, None], s, NEG)
    m = jnp.max(s, axis=-1)
    if sink is not None:
        sk = sink.astype(jnp.float32).reshape(Hkv, G)[None, None, :, :, None]
        m = jnp.maximum(m, sk)
    e = jnp.exp(s - m[..., None])
    denom = jnp.sum(e, axis=-1)
    if sink is not None:
        denom = denom + jnp.exp(sk - m)
    p = e / denom[..., None]
    lse = m + jnp.log(denom)
    o = jnp.einsum('bnhgqk,bnkhd->bnqhgd', p.astype(v.dtype), vb)
    o = o.reshape(Bn, L, Hq, dh)
    lse = lse.transpose(0, 1, 4, 2, 3).reshape(Bn, L, Hq)
    return o, lse


def to_strided(t, d, Sp):
    Bn, S = t.shape[:2]
    t = jnp.pad(t, [(0, 0), (0, Sp - S)] + [(0, 0)] * (t.ndim - 2))
    t = t.reshape((Bn, Sp // d, d) + t.shape[2:])
    t = jnp.moveaxis(t, 2, 1)
    return t.reshape((Bn * d, Sp // d) + t.shape[3:])


def from_strided(t, d, Bn, S):
    Sp = t.shape[1] * d
    t = t.reshape((Bn, d, Sp // d) + t.shape[2:])
    t = jnp.moveaxis(t, 1, 2).reshape((Bn, Sp) + t.shape[3:])
    return t[:, :S]


def dilated_mixture(q, k, v, table_b):
    Bn, S = q.shape[:2]
    outs, lses = [], []
    for (w, d) in B_PATTERNS:
        span = d * BLK
        Sp = -(-S // span) * span
        o, lse = banded_attention(to_strided(q, d, Sp), to_strided(k, d, Sp), to_strided(v, d, Sp),
                                  table_b, w // d, d)
        outs.append(from_strided(o, d, Bn, S))
        lses.append(from_strided(lse, d, Bn, S))
    alpha = jax.nn.softmax(jnp.stack(lses, axis=0), axis=0)
    o = jnp.einsum('pbsh,pbshd->bshd', alpha, jnp.stack(outs, axis=0).astype(jnp.float32))
    return o.astype(q.dtype)


def diff_attention(q, k, v, table_c, lam):
    Bn, S, H, _, dh = q.shape
    nb = S // BLK
    qb = jnp.moveaxis(q.reshape(Bn, nb, BLK, H, 2, dh), 1, 0)
    kpos = jnp.arange(S)
    scale = 1.0 / math.sqrt(dh)

    def block(args):
        i, qi = args
        dist = (i * BLK + jnp.arange(BLK))[:, None] - kpos[None, :]
        bias = table_c[rel_bucket(dist)].astype(jnp.float32).transpose(2, 0, 1)
        s = jnp.einsum('bqhmd,bkhmd->bhmqk', qi, k, preferred_element_type=jnp.float32) * scale
        s = s + bias[None, :, None]
        s = jnp.where((dist >= 0)[None, None, None], s, NEG)
        p = jax.nn.softmax(s, axis=-1)
        a = p[:, :, 0] - lam * p[:, :, 1]
        return jnp.einsum('bhqk,bkhe->bqhe', a.astype(v.dtype), v)

    o = lax.map(block, (jnp.arange(nb), qb))
    return jnp.moveaxis(o, 0, 1).reshape(Bn, S, H, C_V_DIM)


def hybrid_layer(x, c_act, layer_idx, rel_table, w_in, w_out, w_ada, b_ada, g_pre, g_post,
                 a_sinks, lam_q1, lam_k1, lam_q2, lam_k2, g_sub):
    Bn, S, _ = x.shape
    mod = c_act @ w_ada + b_ada
    shift, scale, gate = jnp.split(mod, 3, axis=-1)
    h = rms_norm(x, g_pre) * (1 + scale[:, None]) + shift[:, None]
    proj = h @ w_in
    cuts, acc = [], 0
    for sz in PROJ_SIZES[:-1]:
        acc += sz
        cuts.append(acc)
    aq, ak, av, bq, bk, bv, cq, ck, cv, z = jnp.split(proj, cuts, axis=-1)

    ya, _ = banded_attention(aq.reshape(Bn, S, A_Q_HEADS, HEAD_DIM),
                             ak.reshape(Bn, S, A_KV_HEADS, HEAD_DIM),
                             av.reshape(Bn, S, A_KV_HEADS, HEAD_DIM),
                             rel_table[:, :A_Q_HEADS], A_WINDOW - 1, 1, sink=a_sinks)
    ya = ya.reshape(Bn, S, A_WIDTH)

    yb = dilated_mixture(bq.reshape(Bn, S, B_HEADS, HEAD_DIM), bk.reshape(Bn, S, B_HEADS, HEAD_DIM),
                         bv.reshape(Bn, S, B_HEADS, HEAD_DIM),
                         rel_table[:, A_Q_HEADS:A_Q_HEADS + B_HEADS])
    yb = yb.reshape(Bn, S, B_WIDTH)

    lam_init = 0.8 - 0.6 * math.exp(-0.3 * layer_idx)
    lam = (jnp.exp(jnp.sum(lam_q1.astype(jnp.float32) * lam_k1.astype(jnp.float32)))
           - jnp.exp(jnp.sum(lam_q2.astype(jnp.float32) * lam_k2.astype(jnp.float32))) + lam_init)
    yc = diff_attention(cq.reshape(Bn, S, C_HEADS, 2, HEAD_DIM), ck.reshape(Bn, S, C_HEADS, 2, HEAD_DIM),
                        cv.reshape(Bn, S, C_HEADS, C_V_DIM), rel_table[:, A_Q_HEADS + B_HEADS:], lam)
    yc = (rms_norm(yc, g_sub) * (1.0 - lam_init)).reshape(Bn, S, C_WIDTH)

    y = jnp.concatenate([ya, yb, yc], axis=-1) * jax.nn.silu(z)
    y = y @ w_out
    return x + gate[:, None] * rms_norm(y, g_post)


def setup_inputs(seed: int = 0) -> dict:
    key = jax.random.key(seed)
    ks = jax.random.split(key, 16)
    f32 = jnp.float32
    nrm = lambda k, shape, s: jax.random.normal(k, shape, f32) * s
    return {
        'x': nrm(ks[0], (BATCH, SEQ, D_MODEL), 1.0),
        'c': nrm(ks[1], (BATCH, D_MODEL), 1.0),
        'rel_table': nrm(ks[2], (REL_BUCKETS, N_BIAS_HEADS), 0.5),
        'w_in': nrm(ks[3], (DEPTH, D_MODEL, PROJ_OUT), D_MODEL ** -0.5),
        'w_out': nrm(ks[4], (DEPTH, D_MIX, D_MODEL), D_MIX ** -0.5),
        'w_ada': nrm(ks[5], (DEPTH, D_MODEL, 3 * D_MODEL), 0.5 * D_MODEL ** -0.5),
        'b_ada': nrm(ks[6], (DEPTH, 3 * D_MODEL), 0.01),
        'g_pre': 1.0 + nrm(ks[7], (DEPTH, D_MODEL), 0.05),
        'g_post': 1.0 + nrm(ks[8], (DEPTH, D_MODEL), 0.05),
        'a_sinks': nrm(ks[9], (DEPTH, A_Q_HEADS), 0.5),
        'lam_q1': nrm(ks[10], (DEPTH, HEAD_DIM), 0.1),
        'lam_k1': nrm(ks[11], (DEPTH, HEAD_DIM), 0.1),
        'lam_q2': nrm(ks[12], (DEPTH, HEAD_DIM), 0.1),
        'lam_k2': nrm(ks[13], (DEPTH, HEAD_DIM), 0.1),
        'g_sub': 1.0 + nrm(ks[14], (DEPTH, C_V_DIM), 0.05),
    }


def reference(x, c, rel_table, w_in, w_out, w_ada, b_ada, g_pre, g_post, a_sinks,
              lam_q1, lam_k1, lam_q2, lam_k2, g_sub):
    c_act = jax.nn.silu(c)
    for l in range(DEPTH):
        x = hybrid_layer(x, c_act, l, rel_table, w_in[l], w_out[l], w_ada[l], b_ada[l], g_pre[l],
                         g_post[l], a_sinks[l], lam_q1[l], lam_k1[l], lam_q2[l], lam_k2[l], g_sub[l])
    return x
```

```cpp
#include <hip/hip_runtime.h>
#include <hip/hip_cooperative_groups.h>
#include <cstdio>
#include <cstdint>
namespace cg = cooperative_groups;

typedef unsigned short u16;
using bf16x8 = __attribute__((ext_vector_type(8))) short;
using s16x4  = __attribute__((ext_vector_type(4))) short;
using f32x16 = __attribute__((ext_vector_type(16))) float;
using f32x4  = __attribute__((ext_vector_type(4))) float;
using u32x4  = __attribute__((ext_vector_type(4))) unsigned;
using u32x2  = __attribute__((ext_vector_type(2))) unsigned;
typedef __bf16 bf2_t __attribute__((ext_vector_type(2)));
typedef float fl2_t __attribute__((ext_vector_type(2)));
typedef short v4i16_t __attribute__((ext_vector_type(4)));
#define LAS __attribute__((address_space(3)))
typedef LAS const char* lptr;

#define DI __device__ __forceinline__
#define MFMA(a, b, c) __builtin_amdgcn_mfma_f32_32x32x16_bf16((a), (b), (c), 0, 0, 0)

constexpr int DM = 1024, SEQ = 8192, PO = 7168, PON = 7040, HT = 16384;
constexpr int NTHR = 512, NWAVE = 8;
constexpr int OFF_AQ = 0, OFF_AK = 768, OFF_AV = 960, OFF_BQ = 1152, OFF_BK = 1920, OFF_BV = 2688,
              OFF_CQ = 3456, OFF_CK = 3968, OFF_CV = 4480, OFF_Z = 4992;
constexpr float LOG2E = 1.4426950408889634f, LN2 = 0.6931471805599453f;
constexpr float SC2 = 0.125f * LOG2E;
constexpr float EPS = 1e-6f;

constexpr size_t WS_CTR = 0;
constexpr size_t WS_MOD = 4096;
constexpr size_t WS_LAM = 110592;
constexpr size_t WS_BAR = 112640;
constexpr size_t WS_TABB = 131072;
constexpr size_t WS_TABC = WS_TABB + 4 * 12 * 384 * 4;
constexpr size_t WS_WIN = 1u << 20;
constexpr size_t WS_WOUT = WS_WIN + (size_t)2 * 7168 * 1024 * 2;
constexpr size_t WS_HH = WS_WOUT + (size_t)2 * 1024 * 2048 * 2;
constexpr size_t WS_Y2 = WS_HH + (size_t)HT * 1024 * 2;
constexpr size_t WS_PBO = WS_Y2 + (size_t)HT * 1024 * 4;
constexpr size_t WS_PBL = WS_PBO + (size_t)3 * HT * 768 * 2;
constexpr size_t WS_PH = WS_PBL + (size_t)3 * HT * 12 * 4;
constexpr size_t WS_END = WS_PH + (size_t)HT * PO * 2;

constexpr int LDS_BYTES = 139904;
constexpr int LDS_CTAB = 131072;
constexpr int LDS_XB = 139776;
constexpr int LDS_SLOT = 139792;

struct Params {
    const float *x, *c, *rel, *w_in, *w_out, *w_ada, *b_ada, *g_pre, *g_post, *sinks, *lq1, *lk1, *lq2, *lk2, *g_sub;
    float* out;
    unsigned char* ws;
};

DI unsigned pk2(float lo, float hi) { fl2_t f = {lo, hi}; bf2_t b = __builtin_convertvector(f, bf2_t); return __builtin_bit_cast(unsigned, b); }
DI float bflo(unsigned u) { return __uint_as_float(u << 16); }
DI float bfhi(unsigned u) { return __uint_as_float(u & 0xffff0000u); }
DI float swap32f(float v) { auto rr = __builtin_amdgcn_permlane32_swap(__float_as_uint(v), __float_as_uint(v), false, false);
    return __uint_as_float(rr[0]) ; }
DI float xhalf_max(float v) { auto rr = __builtin_amdgcn_permlane32_swap(__float_as_uint(v), __float_as_uint(v), false, false);
    return fmaxf(__uint_as_float(rr[0]), __uint_as_float(rr[1])); }
DI float xhalf_sum(float v) { auto rr = __builtin_amdgcn_permlane32_swap(__float_as_uint(v), __float_as_uint(v), false, false);
    return __uint_as_float(rr[0]) + __uint_as_float(rr[1]); }
DI float wave_sum(float v) {
#pragma unroll
    for (int o = 1; o < 64; o <<= 1) v += __shfl_xor(v, o);
    return v;
}
DI int get_tid() { int t = threadIdx.x; asm volatile("" : "+v"(t)); return t; }
DI float silu_f(float z) { return z / (1.f + __expf(-z)); }
DI float afma(float a, float b, float c) { float d; asm("v_fma_f32 %0, %1, %2, %3" : "=v"(d) : "v"(a), "v"(b), "v"(c)); return d; }
DI float aadd(float a, float b) { float d; asm("v_add_f32 %0, %1, %2" : "=v"(d) : "v"(a), "v"(b)); return d; }
DI float amax3(float a, float b, float c) { float d; asm("v_max3_f32 %0, %1, %2, %3" : "=v"(d) : "v"(a), "v"(b), "v"(c)); return d; }
DI float asub(float a, float b) { float d; asm("v_sub_f32 %0, %1, %2" : "=v"(d) : "v"(a), "v"(b)); return d; }
DI s16x4 vtr(lptr p) { return __builtin_bit_cast(s16x4, __builtin_amdgcn_ds_read_tr16_b64_v4i16((LAS v4i16_t*)p)); }

__device__ int rel_bucket_dev(int n) {
    if (n < 0) n = 0;
    if (n < 16) return n;
    float nf = (float)n;
    int large = 16 + (int)(logf(nf / 16.f) / 4.852030263919617f * 16.f);
    return large < 31 ? large : 31;
}

DI void phase_w(const Params& P, char* lds) {
    const int tid = get_tid();
    const int half = tid >> 8, t = tid & 255;
    constexpr int NI_IN = 2 * 16 * 110, NI_OUT = 2 * 32 * 16, NI_MOD = 96;
    u16* win_t = (u16*)(P.ws + WS_WIN);
    u16* wout_t = (u16*)(P.ws + WS_WOUT);
    for (int pr = blockIdx.x; pr < (NI_IN + NI_OUT + NI_MOD) / 2; pr += gridDim.x) {
        const int it = 2 * pr + half;
        if (it < NI_IN + NI_OUT) {
            const float* W; u16* WT; int K, N, kt, nt;
            if (it < NI_IN) { int l = it / 1760, r = it % 1760; K = 1024; N = 7040; W = P.w_in + (size_t)l * 1024 * 7040; WT = win_t + (size_t)l * 7168 * 1024; kt = r / 110; nt = r % 110; }
            else { int r0 = it - NI_IN; int l = r0 / 512, r = r0 % 512; K = 2048; N = 1024; W = P.w_out + (size_t)l * 2048 * 1024; WT = wout_t + (size_t)l * 1024 * 2048; kt = r / 16; nt = r % 16; }
            float* tile = (float*)(lds + half * 16896);
            const int ty = t >> 4, tx = t & 15;
#pragma unroll
            for (int i = 0; i < 4; ++i) {
                int k = ty + 16 * i;
                f32x4 v = *(const f32x4*)(W + (size_t)(kt * 64 + k) * N + nt * 64 + tx * 4);
                tile[k * 65 + tx * 4 + 0] = v.x; tile[k * 65 + tx * 4 + 1] = v.y; tile[k * 65 + tx * 4 + 2] = v.z; tile[k * 65 + tx * 4 + 3] = v.w;
            }
            __syncthreads();
            const int n = t >> 2, kc = t & 3;
            unsigned o[8];
#pragma unroll
            for (int j = 0; j < 8; ++j) o[j] = pk2(tile[(kc * 16 + 2 * j) * 65 + n], tile[(kc * 16 + 2 * j + 1) * 65 + n]);
            u32x4* dst = (u32x4*)(WT + (size_t)(nt * 64 + n) * K + kt * 64 + kc * 16);
            u32x4 a = {o[0], o[1], o[2], o[3]}, b = {o[4], o[5], o[6], o[7]};
            dst[0] = a; dst[1] = b;
            __syncthreads();
        } else {
            const int mi = it - NI_IN - NI_OUT; const int l = mi / 48, cb = mi % 48;
            float* cact = (float*)lds;
            float* red = (float*)(lds + 16384 + half * 4096);
            for (int idx = tid; idx < 4096; idx += NTHR) { float cv = P.c[idx]; cact[idx] = cv / (1.f + expf(-cv)); }
            __syncthreads();
            const int j = t & 63, ks = t >> 6; const int col = cb * 64 + j;
            float a0 = 0.f, a1 = 0.f, a2 = 0.f, a3 = 0.f;
            const float* wp = P.w_ada + (size_t)l * 1024 * 3072 + col;
#pragma unroll 8
            for (int k = ks * 256; k < ks * 256 + 256; ++k) {
                float w = wp[(size_t)k * 3072];
                a0 += cact[k] * w; a1 += cact[1024 + k] * w; a2 += cact[2048 + k] * w; a3 += cact[3072 + k] * w;
            }
            red[(ks * 4 + 0) * 64 + j] = a0; red[(ks * 4 + 1) * 64 + j] = a1; red[(ks * 4 + 2) * 64 + j] = a2; red[(ks * 4 + 3) * 64 + j] = a3;
            __syncthreads();
            {
                const int b = t >> 6;
                float s = red[(0 * 4 + b) * 64 + j] + red[(1 * 4 + b) * 64 + j] + red[(2 * 4 + b) * 64 + j] + red[(3 * 4 + b) * 64 + j];
                s += P.b_ada[l * 3072 + col];
                ((float*)(P.ws + WS_MOD))[(l * 4 + b) * 3072 + col] = s;
            }
            __syncthreads();
        }
    }
    {
        u32x4 z = {0u, 0u, 0u, 0u};
        for (int i = blockIdx.x * NTHR + tid; i < 32768; i += gridDim.x * NTHR) {
            const int l = i >> 14, o = i & 16383;
            *(u32x4*)(win_t + ((size_t)l * 7168 + 7040) * 1024 + (size_t)o * 8) = z;
        }
    }
    if (blockIdx.x == gridDim.x - 1) {
        float* tabB = (float*)(P.ws + WS_TABB);
        float* tabC = (float*)(P.ws + WS_TABC);
        for (int idx = tid; idx < 4 * 12 * 384; idx += NTHR) {
            int type = idx / (12 * 384); int head = (idx / 384) % 12; int ii = idx % 384; int dist = ii - 128;
            int maxd = type == 0 ? 127 : 128; int dscale = type <= 1 ? 1 : (type == 2 ? 4 : 16); int col = type == 0 ? head : 12 + head;
            float val = -INFINITY;
            if (dist >= 0 && dist <= maxd) val = P.rel[rel_bucket_dev(dist * dscale) * 28 + col] * LOG2E;
            tabB[idx] = val;
        }
        for (int idx = tid; idx < 4 * 2112; idx += NTHR) {
            int h = idx / 2112; int ii = idx % 2112; int dist = ii - 64;
            float val = -INFINITY;
            if (dist >= 0) val = P.rel[rel_bucket_dev(dist) * 28 + 24 + h] * LOG2E;
            tabC[idx] = val;
        }
        if (tid < 2) {
            int l = tid; float s1 = 0.f, s2 = 0.f;
            for (int i = 0; i < 64; ++i) { s1 += P.lq1[l * 64 + i] * P.lk1[l * 64 + i]; s2 += P.lq2[l * 64 + i] * P.lk2[l * 64 + i]; }
            float lam_init = 0.8f - 0.6f * expf(-0.3f * (float)l);
            ((float*)(P.ws + WS_LAM))[l] = expf(s1) - expf(s2) + lam_init;
        }
        if (tid < 64) ((unsigned*)(P.ws + WS_CTR))[tid] = 0u;
    }
}

DI void phase_n(const Params& P, int hb) {
    const int tid = get_tid(); const int lane = tid & 63, wid = tid >> 6;
    const float* mod = (const float*)(P.ws + WS_MOD);
    u16* Hh = (u16*)(P.ws + WS_HH);
    for (int row = blockIdx.x * NWAVE + wid; row < HT; row += gridDim.x * NWAVE) {
        const int grow = hb * HT + row; const int b = grow / SEQ;
        const f32x4* xr = (const f32x4*)(P.x + (size_t)grow * DM);
        f32x4 v[4]; float ss = 0.f;
#pragma unroll
        for (int j = 0; j < 4; ++j) { v[j] = xr[lane + 64 * j]; ss += v[j].x * v[j].x + v[j].y * v[j].y + v[j].z * v[j].z + v[j].w * v[j].w; }
        const float rstd = rsqrtf(wave_sum(ss) * (1.f / DM) + EPS);
        const f32x4* g = (const f32x4*)(P.g_pre);
        const f32x4* sh = (const f32x4*)(mod + (0 * 4 + b) * 3072);
        const f32x4* sc = (const f32x4*)(mod + (0 * 4 + b) * 3072 + 1024);
        u32x2* o8 = (u32x2*)(Hh + (size_t)row * DM);
#pragma unroll
        for (int j = 0; j < 4; ++j) {
            const int c4 = lane + 64 * j; f32x4 gg = g[c4], s1 = sc[c4], s0 = sh[c4];
            float h0 = v[j].x * rstd * gg.x * (1.f + s1.x) + s0.x, h1 = v[j].y * rstd * gg.y * (1.f + s1.y) + s0.y;
            float h2 = v[j].z * rstd * gg.z * (1.f + s1.z) + s0.z, h3 = v[j].w * rstd * gg.w * (1.f + s1.w) + s0.w;
            u32x2 o = {pk2(h0, h1), pk2(h2, h3)}; o8[c4] = o;
        }
    }
}

DI void phase_f(const Params& P, int hb, int l) {
    const int tid = get_tid(); const int lane = tid & 63, wid = tid >> 6;
    const float* mod = (const float*)(P.ws + WS_MOD);
    u16* Hh = (u16*)(P.ws + WS_HH);
    const u16* Y2 = (const u16*)(P.ws + WS_Y2);
    const float* xin_base = l == 0 ? P.x : P.out;
    for (int row = blockIdx.x * NWAVE + wid; row < HT; row += gridDim.x * NWAVE) {
        const int grow = hb * HT + row; const int b = grow / SEQ;
        const u32x2* yr = (const u32x2*)(Y2 + (size_t)row * DM);
        const f32x4* xr = (const f32x4*)(xin_base + (size_t)grow * DM);
        f32x4 v[4], xv[4]; float ss = 0.f;
#pragma unroll
        for (int j = 0; j < 4; ++j) { const u32x2 yy = yr[lane + 64 * j]; v[j].x = bflo(yy.x); v[j].y = bfhi(yy.x); v[j].z = bflo(yy.y); v[j].w = bfhi(yy.y);
            xv[j] = xr[lane + 64 * j]; ss += v[j].x * v[j].x + v[j].y * v[j].y + v[j].z * v[j].z + v[j].w * v[j].w; }
        const float rstd = rsqrtf(wave_sum(ss) * (1.f / DM) + EPS);
        const f32x4* g = (const f32x4*)(P.g_post + l * DM);
        const f32x4* gt = (const f32x4*)(mod + (l * 4 + b) * 3072 + 2048);
        f32x4* orow = (f32x4*)(P.out + (size_t)grow * DM);
        float ss2 = 0.f;
#pragma unroll
        for (int j = 0; j < 4; ++j) {
            const int c4 = lane + 64 * j; f32x4 gg = g[c4], ga = gt[c4];
            xv[j].x += ga.x * (v[j].x * rstd * gg.x); xv[j].y += ga.y * (v[j].y * rstd * gg.y);
            xv[j].z += ga.z * (v[j].z * rstd * gg.z); xv[j].w += ga.w * (v[j].w * rstd * gg.w);
            orow[c4] = xv[j];
            ss2 += xv[j].x * xv[j].x + xv[j].y * xv[j].y + xv[j].z * xv[j].z + xv[j].w * xv[j].w;
        }
        if (l == 0) {
            const float rstd2 = rsqrtf(wave_sum(ss2) * (1.f / DM) + EPS);
            const f32x4* g1 = (const f32x4*)(P.g_pre + DM);
            const f32x4* sh = (const f32x4*)(mod + (1 * 4 + b) * 3072);
            const f32x4* sc = (const f32x4*)(mod + (1 * 4 + b) * 3072 + 1024);
            u32x2* o8 = (u32x2*)(Hh + (size_t)row * DM);
#pragma unroll
            for (int j = 0; j < 4; ++j) {
                const int c4 = lane + 64 * j; f32x4 gg = g1[c4], s1 = sc[c4], s0 = sh[c4];
                float h0 = xv[j].x * rstd2 * gg.x * (1.f + s1.x) + s0.x, h1 = xv[j].y * rstd2 * gg.y * (1.f + s1.y) + s0.y;
                float h2 = xv[j].z * rstd2 * gg.z * (1.f + s1.z) + s0.z, h3 = xv[j].w * rstd2 * gg.w * (1.f + s1.w) + s0.w;
                u32x2 o = {pk2(h0, h1), pk2(h2, h3)}; o8[c4] = o;
            }
        }
    }
}

DI void glds16(const void* g, unsigned lds_base) {
    unsigned sv; asm volatile("s_mov_b32 %0, m0\n\ts_mov_b32 m0, %2\n\ts_nop 0\n\tglobal_load_lds_dwordx4 %1, off\n\ts_mov_b32 m0, %0" : "=&s"(sv) : "v"(g), "s"(lds_base) : "memory"); }
namespace pg8 {
constexpr int BM = 256, BK = 64, HALF = 128, HTB = HALF * BK * 2  ;
DI int lds_byte(int r, int c) { const int st = (r >> 4) * 2 + (c >> 5), rr = r & 15, cc = c & 31, ob = rr * 64 + cc * 2; return st * 1024 + (ob ^ (((ob >> 9) & 1) << 5)); }
DI void stage_rc(int b, int& R, int& C) { const int st = b / 1024, sb = b % 1024, swz = sb ^ (((sb >> 9) & 1) << 5); R = (st >> 1) * 16 + swz / 64; C = (st & 1) * 32 + (swz % 64) / 2; }
DI int perm32(int rho) { const int n = rho >> 4, i = rho & 15; return 8 * (i >> 2) + 4 * n + (i & 3); }
struct Unit { int pm, pn; };
DI bool next_unit(int i, int nunits, Unit& u) {
    const int L = i * (int)gridDim.x + (int)blockIdx.x; if (L >= nunits) return false;
    const int i2 = L >> 8, b = L & 255, x = b & 7, j = b >> 3; u.pm = 8 * x + (j & 7); u.pn = 4 * i2 + (j >> 3); return true;
}
template <bool REMAP>
DI void gemm_phase(LAS unsigned char* lds, const u16* A, int lda, const u16* Bt, int K, u16* O, int ldc, int nunits) {
    const int tid = get_tid(), wid = __builtin_amdgcn_readfirstlane(tid >> 6), lane = tid & 63, wr = wid >> 2, wc = wid & 3, fr = lane & 15, fq = lane >> 4;
    const int nt = K / BK;
    unsigned voffA[2], voffB[2];
#pragma unroll
    for (int i = 0; i < 2; ++i) { int R, C; stage_rc(tid * 16 + i * 8192, R, C); const int Rb = (R & ~31) + perm32(R & 31);
        voffA[i] = (unsigned)(R * lda + C) * 2u; voffB[i] = (unsigned)(Rb * K + C) * 2u; }
    const size_t kstep = (size_t)(BK * 2);
    const size_t hstepA = (size_t)HALF * lda * 2, hstepB = (size_t)HALF * K * 2;
    const size_t tstepA = 2 * hstepA, tstepB = 2 * hstepB;
    auto akb = [&](int kt) -> size_t { const int k0 = kt * BK; return (size_t)(REMAP ? (k0 < 768 ? k0 : (k0 < 1536 ? k0 + 384 : k0 + 1920)) : k0) * 2; };
    const unsigned ldsw = (unsigned)wid * 1024u;
    const int aoff = lds_byte(wr * 64 + fr, fq * 8), boff = lds_byte(wc * 32 + fr, fq * 8);
#define PG8_SA(b, h) (((b) * 2 + (h)) * HTB)
#define PG8_SB(b, h) ((4 + (b) * 2 + (h)) * HTB)
#define PG8_STAGE(bufoff, gbase, voff) do { _Pragma("unroll") for (int _i = 0; _i < 2; ++_i) \
        __builtin_amdgcn_global_load_lds((const unsigned*)((const char*)(gbase) + (voff)[_i]), (LAS unsigned*)(lds + (bufoff) + ldsw + _i * 8192), 16, 0, 0); } while (0)
#define PG8_LDA(dst, b, h) do { _Pragma("unroll") for (int m = 0; m < 4; ++m) _Pragma("unroll") for (int k = 0; k < 2; ++k) dst[m][k] = *(const LAS bf16x8*)(lds + PG8_SA(b, h) + aoff + m * 2048 + k * 1024); } while (0)
#define PG8_LDB(dst, b, h) do { _Pragma("unroll") for (int n = 0; n < 2; ++n) _Pragma("unroll") for (int k = 0; k < 2; ++k) dst[n][k] = *(const LAS bf16x8*)(lds + PG8_SB(b, h) + boff + n * 2048 + k * 1024); } while (0)
#define PG8_MMA(ai, bj, At, Bt_) do { __builtin_amdgcn_s_setprio(1); _Pragma("unroll") for (int m = 0; m < 4; ++m) _Pragma("unroll") for (int n = 0; n < 2; ++n) _Pragma("unroll") for (int k = 0; k < 2; ++k) \
        acc[ai][bj][m][n] = __builtin_amdgcn_mfma_f32_16x16x32_bf16(Bt_[n][k], At[m][k], acc[ai][bj][m][n], 0, 0, 0); __builtin_amdgcn_s_setprio(0); } while (0)
#define PG8_WAIT_V(n) asm volatile("s_waitcnt vmcnt(" #n ")" ::: "memory")
#define PG8_WAIT_L(n) asm volatile("s_waitcnt lgkmcnt(" #n ")" ::: "memory")
#define PG8_BAR __builtin_amdgcn_s_barrier()
#define PG8_SCHED __builtin_amdgcn_sched_barrier(0)
    Unit cur, nxt; int ui = 0;
    if (!next_unit(0, nunits, cur)) return;
    f32x4 acc[2][2][4][2];
#pragma unroll
    for (int a = 0; a < 2; ++a)
#pragma unroll
        for (int b = 0; b < 2; ++b)
#pragma unroll
            for (int m = 0; m < 4; ++m)
#pragma unroll
                for (int n = 0; n < 2; ++n) acc[a][b][m][n] = (f32x4){0.f, 0.f, 0.f, 0.f};
    bf16x8 At[4][2], B0[2][2], B1[2][2];
    const char* cA = (const char*)A + (size_t)cur.pm * tstepA; const char* cB = (const char*)Bt + (size_t)cur.pn * tstepB;
    PG8_STAGE(PG8_SB(0, 0), cB, voffB); PG8_STAGE(PG8_SA(0, 0), cA + akb(0), voffA); PG8_STAGE(PG8_SB(0, 1), cB + hstepB, voffB); PG8_STAGE(PG8_SA(0, 1), cA + akb(0) + hstepA, voffA);
    if (wr == 1) PG8_BAR;
    PG8_WAIT_V(4); PG8_BAR;
    PG8_STAGE(PG8_SB(1, 0), cB + kstep, voffB); PG8_STAGE(PG8_SA(1, 0), cA + akb(1), voffA); PG8_STAGE(PG8_SB(1, 1), cB + hstepB + kstep, voffB);
    PG8_WAIT_V(6); PG8_BAR;
    for (;;) {
        const bool has_next = next_unit(ui + 1, nunits, nxt);
        const char* nA = has_next ? (const char*)A + (size_t)nxt.pm * tstepA : cA; const char* nB = has_next ? (const char*)Bt + (size_t)nxt.pn * tstepB : cB;
        for (int t = 0; t < nt; t += 2) {
            const bool last = (t == nt - 2);
            const char* a1 = cA + akb(t + 1);
            const char* a2 = last ? nA + akb(0) : cA + akb(t + 2); const char* b2 = last ? nB : cB + (size_t)(t + 2) * kstep;
            const char* a3 = last ? nA + akb(1) : cA + akb(t + 3); const char* b3 = b2 + kstep;
            PG8_LDB(B0, 0, 0); PG8_SCHED; PG8_LDA(At, 0, 0); PG8_STAGE(PG8_SA(1, 1), a1 + hstepA, voffA);
            PG8_WAIT_L(8); PG8_BAR; PG8_WAIT_L(0); PG8_MMA(0, 0, At, B0); PG8_BAR; PG8_SCHED;
            PG8_LDB(B1, 0, 1); PG8_STAGE(PG8_SB(0, 0), b2, voffB);
            PG8_BAR; PG8_WAIT_L(0); PG8_MMA(0, 1, At, B1); PG8_BAR;
            PG8_LDA(At, 0, 1); PG8_STAGE(PG8_SA(0, 0), a2, voffA);
            PG8_BAR; PG8_WAIT_L(0); PG8_MMA(1, 0, At, B0); PG8_BAR; PG8_SCHED;
            PG8_STAGE(PG8_SB(0, 1), b2 + hstepB, voffB);
            PG8_WAIT_V(6); PG8_BAR; PG8_MMA(1, 1, At, B1); PG8_BAR;
            PG8_LDB(B0, 1, 0); PG8_SCHED; PG8_LDA(At, 1, 0); PG8_STAGE(PG8_SA(0, 1), a2 + hstepA, voffA);
            PG8_WAIT_L(8); PG8_BAR; PG8_WAIT_L(0); PG8_MMA(0, 0, At, B0); PG8_BAR; PG8_SCHED;
            PG8_LDB(B1, 1, 1); PG8_STAGE(PG8_SB(1, 0), b3, voffB);
            PG8_BAR; PG8_WAIT_L(0); PG8_MMA(0, 1, At, B1); PG8_BAR;
            PG8_LDA(At, 1, 1); PG8_STAGE(PG8_SA(1, 0), a3, voffA);
            PG8_BAR; PG8_WAIT_L(0); PG8_MMA(1, 0, At, B0); PG8_BAR; PG8_SCHED;
            PG8_STAGE(PG8_SB(1, 1), b3 + hstepB, voffB);
            PG8_WAIT_V(6); PG8_BAR; PG8_MMA(1, 1, At, B1); PG8_BAR;
        }
        {
            const int row0 = cur.pm * BM + wr * 64 + fr, col0 = cur.pn * BM + wc * 32 + 8 * fq;
#pragma unroll
            for (int ai = 0; ai < 2; ++ai)
#pragma unroll
                for (int m = 0; m < 4; ++m) { u16* rowp = O + (size_t)(row0 + ai * HALF + m * 16) * ldc + col0;
#pragma unroll
                    for (int bj = 0; bj < 2; ++bj) { const f32x4 v0 = acc[ai][bj][m][0], v1 = acc[ai][bj][m][1];
                        u32x4 w = {pk2(v0[0], v0[1]), pk2(v0[2], v0[3]), pk2(v1[0], v1[1]), pk2(v1[2], v1[3])};
                        *(u32x4*)(rowp + bj * HALF) = w; } }
        }
        if (!has_next) break;
#pragma unroll
        for (int a = 0; a < 2; ++a)
#pragma unroll
            for (int b = 0; b < 2; ++b)
#pragma unroll
                for (int m = 0; m < 4; ++m)
#pragma unroll
                    for (int n = 0; n < 2; ++n) acc[a][b][m][n] = (f32x4){0.f, 0.f, 0.f, 0.f};
        cur = nxt; cA = nA; cB = nB; ++ui;
    }
    PG8_WAIT_V(0);
    if (wr == 0) PG8_BAR;
    PG8_BAR;
#undef PG8_SA
#undef PG8_SB
#undef PG8_STAGE
#undef PG8_LDA
#undef PG8_LDB
#undef PG8_MMA
#undef PG8_WAIT_V
#undef PG8_WAIT_L
#undef PG8_BAR
#undef PG8_SCHED
}
}

DI void phase_g1(const Params& P, char* lds, int l) {
    const u16* A = (const u16*)(P.ws + WS_HH);
    const u16* Bt = (const u16*)(P.ws + WS_WIN) + (size_t)l * 7168 * 1024;
    pg8::gemm_phase<false>((LAS unsigned char*)lds, A, DM, Bt, 1024, (u16*)(P.ws + WS_PH), PO, 64 * 28);
}
DI void phase_g2(const Params& P, char* lds, int l) {
    const u16* A = (const u16*)(P.ws + WS_PH);
    const u16* Bt = (const u16*)(P.ws + WS_WOUT) + (size_t)l * 1024 * 2048;
    pg8::gemm_phase<true>((LAS unsigned char*)lds, A, PO, Bt, 2048, (u16*)(P.ws + WS_Y2), DM, 64 * 4);
}

constexpr int GP = 144;
#define ROWMAX32(mx)                                                                                                                   \
    {   float a_ = amax3(p0[0], p0[1], p1[0]), b_ = amax3(p0[2], p0[3], p1[1]);                                                       \
        a_ = amax3(a_, p1[2], p1[3]);                                                                                                 \
        _Pragma("unroll") for (int i = 4; i < 16; i += 4) { a_ = amax3(a_, p0[i], p0[i + 1]); b_ = amax3(b_, p0[i + 2], p0[i + 3]); a_ = amax3(a_, p1[i], p1[i + 1]); b_ = amax3(b_, p1[i + 2], p1[i + 3]); } \
        mx = fmaxf(a_, b_); }
#define ATTN_TAIL(DVT, VADDR)                                                                                                         \
    bf16x8 vf[2][DVT];                                                                                                                \
    _Pragma("unroll") for (int dt = 0; dt < DVT; ++dt) { s16x4 lo = vtr(VADDR(0, dt, 0)), hi = vtr(VADDR(0, dt, 1));                  \
        vf[0][dt] = __builtin_shufflevector(lo, hi, 0, 1, 2, 3, 4, 5, 6, 7); }                                                        \
    __builtin_amdgcn_sched_barrier(0);                                                                                                \
    float mn, ls; const float m_old = m; const float sc2v = SC2;                                                                      \
    if (far) {          \
        float mx;                                                                                                                     \
        __builtin_amdgcn_sched_barrier(0);                                                                                            \
        asm volatile("s_nop 7\n\ts_nop 7\n\ts_nop 3" ::: "memory");             \
        __builtin_amdgcn_sched_barrier(0);                                                                                            \
        ROWMAX32(mx)                                                                                                                  \
        mx = fmaf(xhalf_max(mx), SC2, cfar);                                                                                          \
        mn = fmaxf(m, mx);                                                                                                            \
        const float cb = cfar - mn;                                                                                                   \
        __builtin_amdgcn_sched_barrier(0);                                                                                            \
        _Pragma("unroll") for (int i = 0; i < 16; ++i) { p0[i] = afma(p0[i], sc2v, cb); p1[i] = afma(p1[i], sc2v, cb); }              \
    } else {                                                                                                                          \
        float bb0[16], bb1[16];                                                                                                       \
        _Pragma("unroll") for (int i = 0; i < 16; ++i) { const int c = (i & 3) + 8 * (i >> 2); bb0[i] = tb[63 - c]; bb1[i] = tb[31 - c]; } \
        __builtin_amdgcn_sched_barrier(0);                                                                                            \
        asm volatile("s_nop 7\n\ts_nop 7\n\ts_nop 3" ::: "memory");             \
        __builtin_amdgcn_sched_barrier(0);                                                                                            \
        _Pragma("unroll") for (int i = 0; i < 16; ++i) { p0[i] = afma(p0[i], sc2v, bb0[i]); p1[i] = afma(p1[i], sc2v, bb1[i]); }      \
        float mx;                                                                                                                     \
        ROWMAX32(mx)                                                                                                                  \
        mx = xhalf_max(mx);                                                                                                           \
        mn = fmaxf(m, mx);                                                                                                            \
        _Pragma("unroll") for (int i = 0; i < 16; ++i) { p0[i] = asub(p0[i], mn); p1[i] = asub(p1[i], mn); }                          \
    }                                                                                                                                 \
    _Pragma("unroll") for (int i = 0; i < 16; ++i) { p0[i] = __builtin_amdgcn_exp2f(p0[i]); p1[i] = __builtin_amdgcn_exp2f(p1[i]); }  \
    __builtin_amdgcn_sched_barrier(0);                                                                                                \
    asm volatile("s_nop 1" ::: "memory");                                                  \
    {   float t8[8];                                                                                                                  \
        _Pragma("unroll") for (int i = 0; i < 8; ++i) t8[i] = aadd(aadd(p0[i], p1[i]), aadd(p0[i + 8], p1[i + 8]));                   \
        ls = aadd(aadd(aadd(t8[0], t8[1]), aadd(t8[2], t8[3])), aadd(aadd(t8[4], t8[5]), aadd(t8[6], t8[7])));                        \
    }                                                                                                                                 \
    m = mn;                                                                                                                           \
    if (__builtin_amdgcn_ballot_w64(mn != m_old) != 0ull) {           \
        const float alpha = __builtin_amdgcn_exp2f(m_old - mn);                                                                       \
        l *= alpha;                                                                                                                   \
        _Pragma("unroll") for (int dt = 0; dt < DVT; ++dt)                                                                            \
            _Pragma("unroll") for (int i = 0; i < 16; ++i) O[dt][i] *= alpha;                                                         \
    }                                                                                                                                 \
    l += ls;                                                                                                                          \
    _Pragma("unroll") for (int g = 0; g < 4; ++g) {                                                                                   \
        if (g < 3) {                                                                                                                  \
            _Pragma("unroll") for (int dt = 0; dt < DVT; ++dt) { s16x4 lo = vtr(VADDR(g + 1, dt, 0)), hi = vtr(VADDR(g + 1, dt, 1));  \
                vf[(g + 1) & 1][dt] = __builtin_shufflevector(lo, hi, 0, 1, 2, 3, 4, 5, 6, 7); }                                      \
        }                                                                                                                             \
        u32x4 pw; const int s2 = g & 1;                                                                                               \
        if (g < 2) { pw[0] = pk2(p0[8 * s2 + 0], p0[8 * s2 + 1]); pw[1] = pk2(p0[8 * s2 + 2], p0[8 * s2 + 3]); pw[2] = pk2(p0[8 * s2 + 4], p0[8 * s2 + 5]); pw[3] = pk2(p0[8 * s2 + 6], p0[8 * s2 + 7]); } \
        else { pw[0] = pk2(p1[8 * s2 + 0], p1[8 * s2 + 1]); pw[1] = pk2(p1[8 * s2 + 2], p1[8 * s2 + 3]); pw[2] = pk2(p1[8 * s2 + 4], p1[8 * s2 + 5]); pw[3] = pk2(p1[8 * s2 + 6], p1[8 * s2 + 7]); }        \
        const bf16x8 pf = __builtin_bit_cast(bf16x8, pw);                                                                             \
        __builtin_amdgcn_sched_barrier(0);                                                                                            \
        _Pragma("unroll") for (int dt = 0; dt < DVT; ++dt) O[dt] = MFMA(vf[g & 1][dt], pf, O[dt]);                                    \
        __builtin_amdgcn_sched_barrier(0);                                                                                            \
    }

template <int DVT>
DI void attn_step(lptr sKw, int kpitch, lptr sV, int vpitch, const bf16x8 (&qf)[4], float& m, float& l, f32x16 (&O)[DVT],
                  const LAS float* tb, bool far, float cfar, int lane) {
    const int r = lane & 31, h = lane >> 5;
    f32x16 p0, p1;
#pragma unroll
    for (int i = 0; i < 16; ++i) { p0[i] = 0.f; p1[i] = 0.f; }
    bf16x8 kf[8];
#pragma unroll
    for (int s = 0; s < 4; ++s) {
        kf[2 * s] = *(const LAS bf16x8*)(sKw + r * kpitch + (16 * s + 8 * h) * 2);
        kf[2 * s + 1] = *(const LAS bf16x8*)(sKw + (32 + r) * kpitch + (16 * s + 8 * h) * 2);
    }
    __builtin_amdgcn_sched_barrier(0);
#pragma unroll
    for (int s = 0; s < 4; ++s) { p0 = MFMA(kf[2 * s], qf[s], p0); p1 = MFMA(kf[2 * s + 1], qf[s], p1); }
    const int i16 = lane & 15, q = i16 >> 2, pp = i16 & 3, blk = (lane >> 4) & 1;
    lptr vb = sV + (4 * h + q) * vpitch + (16 * blk + 4 * pp) * 2;
#define VADDR_PAD(g, dt, hi) (vb + (16 * (g) + 8 * (hi)) * vpitch + (dt) * 64)
    ATTN_TAIL(DVT, VADDR_PAD)
#undef VADDR_PAD
}

DI void band_item(const Params& P, char* lds_blk, int layer, int bp) {
    const int tid0 = get_tid(); const int half = tid0 >> 8, tid = tid0 & 255, lane = tid & 63, w = tid >> 6, r = lane & 31, h = lane >> 5;
    char* lds = lds_blk + half * 40960;
    const int type = bp / 768, rem = bp % 768; const int bl = rem / 384, head = 2 * ((rem % 384) / 64) + half, blk = rem % 64;
    const int dil = type <= 1 ? 1 : (type == 2 ? 4 : 16);
    const int nper = 64 / dil; const int residue = blk / nper, nb = blk % nper;
    u16* Ph = (u16*)(P.ws + WS_PH);
    const size_t rs = (size_t)dil * PO;
    const size_t base_row = (size_t)bl * SEQ + residue + (size_t)dil * 128 * nb;
    int qcol, kcol, vcol;
    if (type == 0) { qcol = OFF_AQ + head * 64; kcol = OFF_AK + (head >> 2) * 64; vcol = OFF_AV + (head >> 2) * 64; }
    else { qcol = OFF_BQ + head * 64; kcol = OFF_BK + head * 64; vcol = OFF_BV + head * 64; }
    const u16* qp = Ph + base_row * PO + qcol;
    const u16* kp = Ph + base_row * PO + kcol;
    const u16* vp = Ph + base_row * PO + vcol;
    float* btab = (float*)(lds + 4 * 64 * GP);
    const float* tabg = (const float*)(P.ws + WS_TABB) + (type * 12 + head) * 384;
    for (int i = tid; i < 384; i += 256) btab[i] = tabg[i];
    bf16x8 qf[4];
#pragma unroll
    for (int s = 0; s < 4; ++s) qf[s] = *(const bf16x8*)(qp + (size_t)(32 * w + r) * rs + 16 * s + 8 * h);
    float m = -1e30f, l = 0.f;
    if (type == 0) { m = P.sinks[layer * 12 + head] * LOG2E; l = (h == 0) ? 1.f : 0.f; }
    f32x16 O[2];
#pragma unroll
    for (int dt = 0; dt < 2; ++dt)
#pragma unroll
        for (int i = 0; i < 16; ++i) O[dt][i] = 0.f;
    const int maxd = type == 0 ? 127 : 128;
    const int qpos = 128 + 32 * w + r;
    const int kt0 = (nb == 0 ? 2 : 0);
    u32x4 rk[2], rv[2];
    const int srow = tid >> 3, sch = tid & 7;
    auto gload = [&](int kt) {
#pragma unroll
        for (int j = 0; j < 2; ++j) {
            const ptrdiff_t ro = ((ptrdiff_t)(64 * kt + srow + 32 * j) - 128) * (ptrdiff_t)rs + sch * 8;
            rk[j] = *(const u32x4*)(kp + ro); rv[j] = *(const u32x4*)(vp + ro);
        }
    };
    auto lstore = [&](int b) {
        char* sK = lds + b * (2 * 64 * GP); char* sV = sK + 64 * GP;
#pragma unroll
        for (int j = 0; j < 2; ++j) { *(u32x4*)(sK + (srow + 32 * j) * GP + sch * 16) = rk[j]; *(u32x4*)(sV + (srow + 32 * j) * GP + sch * 16) = rv[j]; }
    };
    gload(kt0); lstore(0);
    for (int kt = kt0; kt < 4; ++kt) {
        if (kt + 1 < 4) gload(kt + 1);
        __syncthreads();
        const int b = (kt - kt0) & 1;
        const bool active = (64 * kt <= 128 + 32 * w + 31) && (64 * kt + 63 >= 128 + 32 * w - maxd);
        if (active) {
            const LAS float* tb = (const LAS float*)btab + (qpos - 64 * kt - 4 * h + 128 - 63);
            lptr sK = (lptr)lds + b * (2 * 64 * GP);
            attn_step<2>(sK, GP, sK + 64 * GP, GP, qf, m, l, O, tb, false, 0.f, lane);
        }
        if (kt + 1 < 4) lstore(b ^ 1);
    }
    __syncthreads();
    const float ltot = xhalf_sum(l);
    const float inv = 1.f / ltot;
    constexpr int OP = 272;
    char* sO = lds + w * (32 * OP);
#pragma unroll
    for (int dt = 0; dt < 2; ++dt)
#pragma unroll
        for (int g = 0; g < 4; ++g) {
            f32x4 o4 = {O[dt][4 * g + 0] * inv, O[dt][4 * g + 1] * inv, O[dt][4 * g + 2] * inv, O[dt][4 * g + 3] * inv};
            *(f32x4*)(sO + r * OP + (32 * dt + 8 * g + 4 * h) * 4) = o4;
        }
    if (type != 0 && h == 0) ((float*)(P.ws + WS_PBL))[((size_t)(type - 1) * HT + base_row + (size_t)(32 * w + r) * dil) * 12 + head] = (m + __builtin_amdgcn_logf(ltot)) * LN2;
    const int ch = lane & 7;
#pragma unroll
    for (int j = 0; j < 4; ++j) {
        const int rl = (lane >> 3) + 8 * j;
        const f32x4 a = *(const f32x4*)(sO + rl * OP + ch * 32), b = *(const f32x4*)(sO + rl * OP + ch * 32 + 16);
        const size_t orow = base_row + (size_t)(32 * w + rl) * dil;
        if (type == 0) {
            const u32x4 zz = *(const u32x4*)(Ph + orow * PO + OFF_Z + head * 64 + ch * 8);
            u32x4 o = {pk2(a.x * silu_f(bflo(zz.x)), a.y * silu_f(bfhi(zz.x))), pk2(a.z * silu_f(bflo(zz.y)), a.w * silu_f(bfhi(zz.y))),
                       pk2(b.x * silu_f(bflo(zz.z)), b.y * silu_f(bfhi(zz.z))), pk2(b.z * silu_f(bflo(zz.w)), b.w * silu_f(bfhi(zz.w)))};
            *(u32x4*)(Ph + orow * PO + OFF_AQ + head * 64 + ch * 8) = o;
        } else {
            u32x4 o = {pk2(a.x, a.y), pk2(a.z, a.w), pk2(b.x, b.y), pk2(b.z, b.w)};
            *(u32x4*)((u16*)(P.ws + WS_PBO) + ((size_t)(type - 1) * HT + orow) * 768 + head * 64 + ch * 8) = o;
        }
    }
}

template <typename F>
DI void diff_step(lptr sK, lptr sV, int kx0, int vl0, const bf16x8 (&qf)[4], float& m, float& l, f32x16 (&O)[4],
                  const LAS float* tb, bool far, float cfar, int lane, F&& mid) {
    const int r = lane & 31;
    f32x16 p0, p1;
#pragma unroll
    for (int i = 0; i < 16; ++i) { p0[i] = 0.f; p1[i] = 0.f; }
    lptr kr = sK + r * 256;
    bf16x8 kf[8];
#pragma unroll
    for (int s = 0; s < 4; ++s) {
        const int co = (kx0 ^ (2 * s)) * 16;
        kf[2 * s] = *(const LAS bf16x8*)(kr + co);
        kf[2 * s + 1] = *(const LAS bf16x8*)(kr + 8192 + co);
    }
    __builtin_amdgcn_sched_barrier(0);
    mid();
    __builtin_amdgcn_sched_barrier(0);
#pragma unroll
    for (int s = 0; s < 4; ++s) { p0 = MFMA(kf[2 * s], qf[s], p0); p1 = MFMA(kf[2 * s + 1], qf[s], p1); }
#define VADDR_SWZ(g, dt, hi) (sV + (vl0 ^ (((dt) << 6) | ((hi) << 5))) + (16 * (g) + 8 * (hi)) * 256)
    ATTN_TAIL(4, VADDR_SWZ)
#undef VADDR_SWZ
}

DI void diff_item(const Params& P, char* lds, int layer, int pair, int qt, int& tab_head) {
    const int tid = get_tid(), lane = tid & 63, w = tid >> 6, r = lane & 31, hh = lane >> 5;
    const int bl = pair >> 2, head = pair & 3;
    const int mp = w >> 2, qs = w & 3;
    u16* Ph = (u16*)(P.ws + WS_PH);
    u16* base = Ph + (size_t)bl * SEQ * PO;
    const int q0 = 128 * qt;
    const int qpos = q0 + 32 * qs + r;
    float* ctab = (float*)(lds + LDS_CTAB);
    const float* tabg = (const float*)(P.ws + WS_TABC) + head * 2112;
    if (tab_head != head) { for (int i = tid; i < 2112; i += NTHR) ctab[i] = tabg[i]; tab_head = head; }
    const float cfar = tabg[2111];
    const unsigned lds0 = (unsigned)(uintptr_t)lds;
    int goff[2];
#pragma unroll
    for (int i = 0; i < 2; ++i) goff[i] = (8 * w + 4 * i + (lane >> 4)) * PO + (((lane & 15) ^ (((lane >> 4) << 2) | ((2 * w + i) & 3))) * 8);
    const u16* kg = base + head * 128 + OFF_CK;
    const u16* vg = base + head * 128 + OFF_CV;
    auto issue = [&](int kt, int buf) {
        const size_t to = (size_t)(64 * kt) * PO;
#pragma unroll
        for (int i = 0; i < 2; ++i) {
            glds16(kg + to + goff[i], (unsigned)__builtin_amdgcn_readfirstlane(lds0 + buf * 32768 + (2 * w + i) * 1024));
            glds16(vg + to + goff[i], (unsigned)__builtin_amdgcn_readfirstlane(lds0 + buf * 32768 + 16384 + (2 * w + i) * 1024));
        }
    };
    issue(0, 0); issue(1, 1);
    bf16x8 qf[4];
#pragma unroll
    for (int s = 0; s < 4; ++s) qf[s] = *(const bf16x8*)(base + (size_t)qpos * PO + OFF_CQ + head * 128 + mp * 64 + 16 * s + 8 * hh);
    float m = -1e30f, l = 0.f;
    f32x16 O[4];
#pragma unroll
    for (int dt = 0; dt < 4; ++dt)
#pragma unroll
        for (int i = 0; i < 16; ++i) O[dt][i] = 0.f;
    const int sig_r = ((r & 3) << 2) | ((r >> 2) & 3);
    const int kx0 = (8 * mp + hh) ^ sig_r;
    const int i16 = lane & 15, q = i16 >> 2, pp = i16 & 3, blk = (lane >> 4) & 1;
    const int vl0 = (4 * hh + q) * 256 + (16 * ((q << 2) | (blk << 1) | ((pp >> 1) ^ hh)) + 8 * (pp & 1));
    const int nkt = 2 * qt + 2;
    for (int kt = 0; kt < nkt; ++kt) {
        if ((kt & 1) == 0) {
            asm volatile("s_waitcnt vmcnt(0)" ::: "memory");
            __syncthreads();
        }
        auto mid = [&]() { if ((kt & 1) == 0) { if (kt + 2 < nkt) issue(kt + 2, (kt + 2) & 3); } else { if (kt + 2 < nkt) issue(kt + 2, (kt + 2) & 3); } };
        if (64 * kt <= q0 + 32 * qs + 31) {
            const bool far = (q0 + 32 * qs) - (64 * kt + 63) >= 1536;
            const LAS float* tb = (const LAS float*)ctab + (qpos - 64 * kt - 4 * hh + 64 - 63);
            lptr bufp = (lptr)lds + (kt & 3) * 32768;
            diff_step(bufp, bufp + 16384, kx0, vl0, qf, m, l, O, tb, far, cfar, lane, mid);
        } else mid();
    }
    __syncthreads();
    const float inv = 1.f / xhalf_sum(l);
    float* cmb = (float*)lds;
    if (mp == 1) {
#pragma unroll
        for (int dt = 0; dt < 4; ++dt)
#pragma unroll
            for (int i = 0; i < 16; ++i) cmb[(qs * 128 + 32 * dt + (i & 3) + 8 * (i >> 2) + 4 * hh) * 32 + r] = O[dt][i] * inv;
    }
    __syncthreads();
    if (mp == 0) {
        const float lam = ((const float*)(P.ws + WS_LAM))[layer];
        const float lam_init = 0.8f - 0.6f * expf(-0.3f * (float)layer);
        float ss = 0.f;
#pragma unroll
        for (int dt = 0; dt < 4; ++dt)
#pragma unroll
            for (int i = 0; i < 16; ++i) {
                float o = O[dt][i] * inv - lam * cmb[(qs * 128 + 32 * dt + (i & 3) + 8 * (i >> 2) + 4 * hh) * 32 + r];
                O[dt][i] = o; ss += o * o;
            }
        ss = xhalf_sum(ss);
        const float rstd = rsqrtf(ss * (1.f / 128.f) + EPS) * (1.f - lam_init);
        const float* gs = P.g_sub + layer * 128;
        u16* orow = base + (size_t)qpos * PO;
#pragma unroll
        for (int dt = 0; dt < 4; ++dt)
#pragma unroll
            for (int g = 0; g < 4; ++g) {
                const int d = 32 * dt + 8 * g + 4 * hh;
                u32x2 zz = *(const u32x2*)(orow + OFF_Z + 1536 + head * 128 + d);
                f32x4 gg = *(const f32x4*)(gs + d);
                float y0 = O[dt][4 * g + 0] * rstd * gg.x * silu_f(bflo(zz.x)), y1 = O[dt][4 * g + 1] * rstd * gg.y * silu_f(bfhi(zz.x));
                float y2 = O[dt][4 * g + 2] * rstd * gg.z * silu_f(bflo(zz.y)), y3 = O[dt][4 * g + 3] * rstd * gg.w * silu_f(bfhi(zz.y));
                u32x2 o = {pk2(y0, y1), pk2(y2, y3)};
                *(u32x2*)(orow + OFF_CQ + head * 128 + d) = o;
            }
    }
    __syncthreads();
}

DI void phase_att(const Params& P, char* lds, int hb, int layer) {
    unsigned* ctr = (unsigned*)(P.ws + WS_CTR) + (hb * 2 + layer) * 8;
    LAS int* slot = (LAS int*)(lds + LDS_SLOT);
    const int tid = get_tid();
    constexpr int NQ = 64 + 384;
    int tab_head = -1;
    for (int dq = 0; dq < 8; ++dq) {
        const int qx = (blockIdx.x + dq) & 7;
        while (true) {
            if (tid == 0) *slot = (int)atomicAdd(&ctr[qx], 1u);
            __syncthreads();
            const int qi = *slot;
            __syncthreads();
            if (qi >= NQ) break;
            if (qi < 64) diff_item(P, lds, layer, qx, 63 - qi, tab_head);
            else band_item(P, lds, layer, qx * 384 + (qi - 64));
        }
    }
}

DI void phase_cmb(const Params& P) {
    u16* Ph = (u16*)(P.ws + WS_PH);
    const u16* pbo = (const u16*)(P.ws + WS_PBO);
    const float* pbl = (const float*)(P.ws + WS_PBL);
    const int tid = get_tid();
    for (int idx = blockIdx.x * NTHR + tid; idx < HT * 96; idx += gridDim.x * NTHR) {
        const int row = idx / 96, c8 = idx % 96; const int head = c8 >> 3;
        float l0 = pbl[((size_t)0 * HT + row) * 12 + head], l1 = pbl[((size_t)1 * HT + row) * 12 + head], l2 = pbl[((size_t)2 * HT + row) * 12 + head];
        float mx = fmaxf(l0, fmaxf(l1, l2));
        float w0 = __expf(l0 - mx), w1 = __expf(l1 - mx), w2 = __expf(l2 - mx);
        const float inv = 1.f / (w0 + w1 + w2); w0 *= inv; w1 *= inv; w2 *= inv;
        u32x4 a = *(const u32x4*)(pbo + ((size_t)0 * HT + row) * 768 + c8 * 8);
        u32x4 b = *(const u32x4*)(pbo + ((size_t)1 * HT + row) * 768 + c8 * 8);
        u32x4 c = *(const u32x4*)(pbo + ((size_t)2 * HT + row) * 768 + c8 * 8);
        u32x4 z = *(const u32x4*)(Ph + (size_t)row * PO + OFF_Z + 768 + c8 * 8);
        u32x4 o;
#pragma unroll
        for (int j = 0; j < 4; ++j) {
            float lo = (w0 * bflo(a[j]) + w1 * bflo(b[j]) + w2 * bflo(c[j])) * silu_f(bflo(z[j]));
            float hi = (w0 * bfhi(a[j]) + w1 * bfhi(b[j]) + w2 * bfhi(c[j])) * silu_f(bfhi(z[j]));
            o[j] = pk2(lo, hi);
        }
        *(u32x4*)(Ph + (size_t)row * PO + OFF_BQ + c8 * 8) = o;
    }
}


#define XB_TMO      128
#define XB_XCNT(j)  (256  + 64 * (j))
#define XB_XSUB(j)  (1280 + 64 * (j))
#define XB_XGEN(j)  (2304 + 64 * (j))
#define XB_TOP      3328
#define XB_TOPGEN   3392
#define XCD_BAR_WORDS 3456
#define XB_SPIN_CAP (1u << 22)
DI unsigned xb_ld(unsigned* p)              { return __hip_atomic_load(p, __ATOMIC_RELAXED, __HIP_MEMORY_SCOPE_AGENT); }
DI unsigned xb_add(unsigned* p, unsigned v) { return __hip_atomic_fetch_add(p, v, __ATOMIC_RELAXED, __HIP_MEMORY_SCOPE_AGENT); }
DI unsigned xb_xcc_id() { return (unsigned)__builtin_amdgcn_s_getreg((3 << 11) | 20) & 0xFu; }
#define XB_SPIN(cond, bar) do { unsigned _sp = 0; while (cond) { __builtin_amdgcn_s_sleep(1); \
    if ((++_sp & 255u) == 0u) { if (xb_ld(&(bar)[XB_TMO])) break; if (_sp > XB_SPIN_CAP) { atomicAdd(&(bar)[XB_TMO], 1u); break; } } } } while (0)
struct XcdBarrier { unsigned* bar; unsigned x; volatile LAS unsigned* st; };
DI XcdBarrier xcd_barrier_post(unsigned* bar, volatile LAS unsigned* st) {
    XcdBarrier b; b.bar = bar; b.x = xb_xcc_id(); b.st = st;
    if (threadIdx.x == 0) (void)xb_add(&bar[XB_XCNT(b.x)], 1u);
    return b;
}
DI void xcd_barrier_complete(unsigned* bar, unsigned x, unsigned& nloc, unsigned& nx) {
    const unsigned G = gridDim.x * gridDim.y * gridDim.z;
    unsigned sum, cnt, mine, sp = 0u;
    for (;;) {
        sum = 0u; cnt = 0u; mine = 0u;
#pragma unroll
        for (unsigned j = 0; j < 16; ++j) { const unsigned c = xb_ld(&bar[XB_XCNT(j)]); sum += c; cnt += (c > 0u) ? 1u : 0u; mine = (j == x) ? c : mine; }
        if (sum == G) break;
        __builtin_amdgcn_s_sleep(1);
        if ((++sp & 255u) == 0u) { if (xb_ld(&bar[XB_TMO])) break; if (sp > XB_SPIN_CAP) { atomicAdd(&bar[XB_TMO], 1u); break; } }
    }
    nloc = mine > 0u ? mine : 1u; nx = cnt > 0u ? cnt : 1u;
}
DI void xcd_barrier(const XcdBarrier& b) {
    asm volatile("s_waitcnt vmcnt(0)" ::: "memory");
    __syncthreads();
    if (threadIdx.x == 0) {
        unsigned* bar = b.bar;
        __builtin_amdgcn_s_waitcnt(0);
        unsigned nloc = b.st[0], nx = b.st[1];
        if (nloc == 0u) { xcd_barrier_complete(bar, b.x, nloc, nx); b.st[0] = nloc; b.st[1] = nx; }
        const unsigned old = xb_add(&bar[XB_XSUB(b.x)], 1u);
        const unsigned gen = old / nloc;
        if (old + 1u == (gen + 1u) * nloc) {
            __builtin_amdgcn_fence(__ATOMIC_RELEASE, "agent");
            asm volatile("s_waitcnt vmcnt(0)" ::: "memory");
            const unsigned og = xb_add(&bar[XB_TOP], 1u);
            const unsigned tg = og / nx;
            if (og + 1u == (tg + 1u) * nx) xb_add(&bar[XB_TOPGEN], 1u);
            else XB_SPIN(xb_ld(&bar[XB_TOPGEN]) == tg, bar);
            __builtin_amdgcn_fence(__ATOMIC_ACQUIRE, "agent");
            xb_add(&bar[XB_XGEN(b.x)], 1u);
            asm volatile("s_waitcnt vmcnt(0)" ::: "memory");
        } else {
            XB_SPIN(xb_ld(&bar[XB_XGEN(b.x)]) == gen, bar);
            __builtin_amdgcn_fence(__ATOMIC_ACQUIRE, "agent");
            asm volatile("s_waitcnt vmcnt(0)" ::: "memory");
        }
    }
    __syncthreads();
}

#define LAUNDER(Q) Params Q = P; asm volatile("" : "+s"(Q.ws), "+s"(Q.out), "+s"(Q.x), "+s"(Q.rel), "+s"(Q.g_sub), "+s"(Q.sinks))
__global__ void __launch_bounds__(512, 1) mega(Params P) {
    extern __shared__ __attribute__((aligned(16))) char lds[];
    cg::grid_group grid = cg::this_grid();
    volatile LAS unsigned* xst = (volatile LAS unsigned*)(lds + LDS_XB);
    if (threadIdx.x == 0) { xst[0] = 0u; xst[1] = 0u; }
    __syncthreads();
    const XcdBarrier xb = xcd_barrier_post((unsigned*)(P.ws + WS_BAR), xst);
    if (__builtin_amdgcn_readfirstlane(threadIdx.x) >= 256) __builtin_amdgcn_s_setprio(1);
    { LAUNDER(Q); phase_w(Q, lds); }
    grid.sync();
#pragma unroll 1
    for (int hb = 0; hb < 2; ++hb) {
        { LAUNDER(Q); phase_n(Q, hb); }
        xcd_barrier(xb);
#pragma unroll 1
        for (int l = 0; l < 2; ++l) {
            { LAUNDER(Q); phase_g1(Q, lds, l); }
            xcd_barrier(xb);
            { LAUNDER(Q); phase_att(Q, lds, hb, l); }
            xcd_barrier(xb);
            { LAUNDER(Q); phase_cmb(Q); }
            xcd_barrier(xb);
            { LAUNDER(Q); phase_g2(Q, lds, l); }
            xcd_barrier(xb);
            { LAUNDER(Q); phase_f(Q, hb, l); }
            if (!(hb == 1 && l == 1)) xcd_barrier(xb);
        }
    }
}

extern "C" void kernel_launch(void* const* d_in, const int* in_sizes, int n_in, void* d_out, int out_size, void* d_ws, size_t ws_size,
                              hipStream_t stream) {
    static int grid_blocks = 0;
    if (!grid_blocks) {
        int dev = 0, cus = 0, per_cu = 0;
        hipGetDevice(&dev);
        hipDeviceGetAttribute(&cus, hipDeviceAttributeMultiprocessorCount, dev);
        hipFuncSetAttribute((const void*)mega, hipFuncAttributeMaxDynamicSharedMemorySize, LDS_BYTES);
        hipOccupancyMaxActiveBlocksPerMultiprocessor(&per_cu, mega, NTHR, LDS_BYTES);
        if (per_cu > 1) per_cu = 1;
        if (per_cu < 1) per_cu = 1;
        grid_blocks = cus * per_cu;
        if (ws_size < WS_END) fprintf(stderr, "kernel_launch: workspace too small: %zu < %zu\n", ws_size, (size_t)WS_END);
    }
    hipMemsetAsync((char*)d_ws + WS_BAR, 0, XCD_BAR_WORDS * 4, stream);
    Params p{};
    p.x = (const float*)d_in[0]; p.c = (const float*)d_in[1]; p.rel = (const float*)d_in[2]; p.w_in = (const float*)d_in[3];
    p.w_out = (const float*)d_in[4]; p.w_ada = (const float*)d_in[5]; p.b_ada = (const float*)d_in[6]; p.g_pre = (const float*)d_in[7];
    p.g_post = (const float*)d_in[8]; p.sinks = (const float*)d_in[9]; p.lq1 = (const float*)d_in[10]; p.lk1 = (const float*)d_in[11];
    p.lq2 = (const float*)d_in[12]; p.lk2 = (const float*)d_in[13]; p.g_sub = (const float*)d_in[14];
    p.out = (float*)d_out; p.ws = (unsigned char*)d_ws;
    void* args[] = {&p};
    hipError_t e = hipLaunchCooperativeKernel((void*)mega, dim3(grid_blocks), dim3(NTHR), args, LDS_BYTES, stream);
    if (e != hipSuccess) fprintf(stderr, "cooperative launch failed: %s (grid %d)\n", hipGetErrorString(e), grid_blocks);
}
```

```cpp
#include <hip/hip_runtime.h>
#include <hip/hip_cooperative_groups.h>
#include <cstdio>
#include <cstdint>
namespace cg = cooperative_groups;

typedef unsigned short u16;
using bf16x8 = __attribute__((ext_vector_type(8))) short;
using s16x4  = __attribute__((ext_vector_type(4))) short;
using f32x16 = __attribute__((ext_vector_type(16))) float;
using f32x4  = __attribute__((ext_vector_type(4))) float;
using u32x4  = __attribute__((ext_vector_type(4))) unsigned;
using u32x2  = __attribute__((ext_vector_type(2))) unsigned;
typedef __bf16 bf2_t __attribute__((ext_vector_type(2)));
typedef float fl2_t __attribute__((ext_vector_type(2)));
typedef short v4i16_t __attribute__((ext_vector_type(4)));
#define LAS __attribute__((address_space(3)))
typedef LAS const char* lptr;

#define DI __device__ __forceinline__
#define MFMA(a, b, c) __builtin_amdgcn_mfma_f32_32x32x16_bf16((a), (b), (c), 0, 0, 0)

constexpr int DM = 1024, SEQ = 8192, PO = 7168, PON = 7040, HT = 16384;
constexpr int NTHR = 512, NWAVE = 8;
constexpr int OFF_AQ = 0, OFF_AK = 768, OFF_AV = 960, OFF_BQ = 1152, OFF_BK = 1920, OFF_BV = 2688,
              OFF_CQ = 3456, OFF_CK = 3968, OFF_CV = 4480, OFF_Z = 4992;
constexpr float LOG2E = 1.4426950408889634f, LN2 = 0.6931471805599453f;
constexpr float SC2 = 0.125f * LOG2E;
constexpr float EPS = 1e-6f;

constexpr size_t WS_CTR = 0;
constexpr size_t WS_MOD = 4096;
constexpr size_t WS_LAM = 110592;
constexpr size_t WS_BAR = 112640;
constexpr size_t WS_TABB = 131072;
constexpr size_t WS_TABC = WS_TABB + 4 * 12 * 384 * 4;
constexpr size_t WS_WIN = 1u << 20;
constexpr size_t WS_WOUT = WS_WIN + (size_t)2 * 7168 * 1024 * 2;
constexpr size_t WS_HH = WS_WOUT + (size_t)2 * 1024 * 2048 * 2;
constexpr size_t WS_Y2 = WS_HH + (size_t)HT * 1024 * 2;
constexpr size_t WS_PBO = WS_Y2 + (size_t)HT * 1024 * 4;
constexpr size_t WS_PBL = WS_PBO + (size_t)3 * HT * 768 * 2;
constexpr size_t WS_PH = WS_PBL + (size_t)3 * HT * 12 * 4;
constexpr size_t WS_END = WS_PH + (size_t)HT * PO * 2;

constexpr int LDS_BYTES = 139904;
constexpr int LDS_CTAB = 131072;
constexpr int LDS_XB = 139776;
constexpr int LDS_SLOT = 139792;

struct Params {
    const float *x, *c, *rel, *w_in, *w_out, *w_ada, *b_ada, *g_pre, *g_post, *sinks, *lq1, *lk1, *lq2, *lk2, *g_sub;
    float* out;
    unsigned char* ws;
};

DI unsigned pk2(float lo, float hi) { fl2_t f = {lo, hi}; bf2_t b = __builtin_convertvector(f, bf2_t); return __builtin_bit_cast(unsigned, b); }
DI float bflo(unsigned u) { return __uint_as_float(u << 16); }
DI float bfhi(unsigned u) { return __uint_as_float(u & 0xffff0000u); }
DI float swap32f(float v) { auto rr = __builtin_amdgcn_permlane32_swap(__float_as_uint(v), __float_as_uint(v), false, false);
    return __uint_as_float(rr[0]) ; }
DI float xhalf_max(float v) { auto rr = __builtin_amdgcn_permlane32_swap(__float_as_uint(v), __float_as_uint(v), false, false);
    return fmaxf(__uint_as_float(rr[0]), __uint_as_float(rr[1])); }
DI float xhalf_sum(float v) { auto rr = __builtin_amdgcn_permlane32_swap(__float_as_uint(v), __float_as_uint(v), false, false);
    return __uint_as_float(rr[0]) + __uint_as_float(rr[1]); }
DI float wave_sum(float v) {
#pragma unroll
    for (int o = 1; o < 64; o <<= 1) v += __shfl_xor(v, o);
    return v;
}
DI int get_tid() { int t = threadIdx.x; asm volatile("" : "+v"(t)); return t; }
DI float silu_f(float z) { return z / (1.f + __expf(-z)); }
DI float afma(float a, float b, float c) { float d; asm("v_fma_f32 %0, %1, %2, %3" : "=v"(d) : "v"(a), "v"(b), "v"(c)); return d; }
DI float aadd(float a, float b) { float d; asm("v_add_f32 %0, %1, %2" : "=v"(d) : "v"(a), "v"(b)); return d; }
DI float amax3(float a, float b, float c) { float d; asm("v_max3_f32 %0, %1, %2, %3" : "=v"(d) : "v"(a), "v"(b), "v"(c)); return d; }
DI float asub(float a, float b) { float d; asm("v_sub_f32 %0, %1, %2" : "=v"(d) : "v"(a), "v"(b)); return d; }
DI s16x4 vtr(lptr p) { return __builtin_bit_cast(s16x4, __builtin_amdgcn_ds_read_tr16_b64_v4i16((LAS v4i16_t*)p)); }

__device__ int rel_bucket_dev(int n) {
    if (n < 0) n = 0;
    if (n < 16) return n;
    float nf = (float)n;
    int large = 16 + (int)(logf(nf / 16.f) / 4.852030263919617f * 16.f);
    return large < 31 ? large : 31;
}

DI void phase_w(const Params& P, char* lds) {
    const int tid = get_tid();
    const int half = tid >> 8, t = tid & 255;
    constexpr int NI_IN = 2 * 16 * 110, NI_OUT = 2 * 32 * 16, NI_MOD = 96;
    u16* win_t = (u16*)(P.ws + WS_WIN);
    u16* wout_t = (u16*)(P.ws + WS_WOUT);
    for (int pr = blockIdx.x; pr < (NI_IN + NI_OUT + NI_MOD) / 2; pr += gridDim.x) {
        const int it = 2 * pr + half;
        if (it < NI_IN + NI_OUT) {
            const float* W; u16* WT; int K, N, kt, nt;
            if (it < NI_IN) { int l = it / 1760, r = it % 1760; K = 1024; N = 7040; W = P.w_in + (size_t)l * 1024 * 7040; WT = win_t + (size_t)l * 7168 * 1024; kt = r / 110; nt = r % 110; }
            else { int r0 = it - NI_IN; int l = r0 / 512, r = r0 % 512; K = 2048; N = 1024; W = P.w_out + (size_t)l * 2048 * 1024; WT = wout_t + (size_t)l * 1024 * 2048; kt = r / 16; nt = r % 16; }
            float* tile = (float*)(lds + half * 16896);
            const int ty = t >> 4, tx = t & 15;
#pragma unroll
            for (int i = 0; i < 4; ++i) {
                int k = ty + 16 * i;
                f32x4 v = *(const f32x4*)(W + (size_t)(kt * 64 + k) * N + nt * 64 + tx * 4);
                tile[k * 65 + tx * 4 + 0] = v.x; tile[k * 65 + tx * 4 + 1] = v.y; tile[k * 65 + tx * 4 + 2] = v.z; tile[k * 65 + tx * 4 + 3] = v.w;
            }
            __syncthreads();
            const int n = t >> 2, kc = t & 3;
            unsigned o[8];
#pragma unroll
            for (int j = 0; j < 8; ++j) o[j] = pk2(tile[(kc * 16 + 2 * j) * 65 + n], tile[(kc * 16 + 2 * j + 1) * 65 + n]);
            u32x4* dst = (u32x4*)(WT + (size_t)(nt * 64 + n) * K + kt * 64 + kc * 16);
            u32x4 a = {o[0], o[1], o[2], o[3]}, b = {o[4], o[5], o[6], o[7]};
            dst[0] = a; dst[1] = b;
            __syncthreads();
        } else {
            const int mi = it - NI_IN - NI_OUT; const int l = mi / 48, cb = mi % 48;
            float* cact = (float*)lds;
            float* red = (float*)(lds + 16384 + half * 4096);
            for (int idx = tid; idx < 4096; idx += NTHR) { float cv = P.c[idx]; cact[idx] = cv / (1.f + expf(-cv)); }
            __syncthreads();
            const int j = t & 63, ks = t >> 6; const int col = cb * 64 + j;
            float a0 = 0.f, a1 = 0.f, a2 = 0.f, a3 = 0.f;
            const float* wp = P.w_ada + (size_t)l * 1024 * 3072 + col;
#pragma unroll 8
            for (int k = ks * 256; k < ks * 256 + 256; ++k) {
                float w = wp[(size_t)k * 3072];
                a0 += cact[k] * w; a1 += cact[1024 + k] * w; a2 += cact[2048 + k] * w; a3 += cact[3072 + k] * w;
            }
            red[(ks * 4 + 0) * 64 + j] = a0; red[(ks * 4 + 1) * 64 + j] = a1; red[(ks * 4 + 2) * 64 + j] = a2; red[(ks * 4 + 3) * 64 + j] = a3;
            __syncthreads();
            {
                const int b = t >> 6;
                float s = red[(0 * 4 + b) * 64 + j] + red[(1 * 4 + b) * 64 + j] + red[(2 * 4 + b) * 64 + j] + red[(3 * 4 + b) * 64 + j];
                s += P.b_ada[l * 3072 + col];
                ((float*)(P.ws + WS_MOD))[(l * 4 + b) * 3072 + col] = s;
            }
            __syncthreads();
        }
    }
    {
        u32x4 z = {0u, 0u, 0u, 0u};
        for (int i = blockIdx.x * NTHR + tid; i < 32768; i += gridDim.x * NTHR) {
            const int l = i >> 14, o = i & 16383;
            *(u32x4*)(win_t + ((size_t)l * 7168 + 7040) * 1024 + (size_t)o * 8) = z;
        }
    }
    if (blockIdx.x == gridDim.x - 1) {
        float* tabB = (float*)(P.ws + WS_TABB);
        float* tabC = (float*)(P.ws + WS_TABC);
        for (int idx = tid; idx < 4 * 12 * 384; idx += NTHR) {
            int type = idx / (12 * 384); int head = (idx / 384) % 12; int ii = idx % 384; int dist = ii - 128;
            int maxd = type == 0 ? 127 : 128; int dscale = type <= 1 ? 1 : (type == 2 ? 4 : 16); int col = type == 0 ? head : 12 + head;
            float val = -INFINITY;
            if (dist >= 0 && dist <= maxd) val = P.rel[rel_bucket_dev(dist * dscale) * 28 + col] * LOG2E;
            tabB[idx] = val;
        }
        for (int idx = tid; idx < 4 * 2112; idx += NTHR) {
            int h = idx / 2112; int ii = idx % 2112; int dist = ii - 64;
            float val = -INFINITY;
            if (dist >= 0) val = P.rel[rel_bucket_dev(dist) * 28 + 24 + h] * LOG2E;
            tabC[idx] = val;
        }
        if (tid < 2) {
            int l = tid; float s1 = 0.f, s2 = 0.f;
            for (int i = 0; i < 64; ++i) { s1 += P.lq1[l * 64 + i] * P.lk1[l * 64 + i]; s2 += P.lq2[l * 64 + i] * P.lk2[l * 64 + i]; }
            float lam_init = 0.8f - 0.6f * expf(-0.3f * (float)l);
            ((float*)(P.ws + WS_LAM))[l] = expf(s1) - expf(s2) + lam_init;
        }
        if (tid < 64) ((unsigned*)(P.ws + WS_CTR))[tid] = 0u;
    }
}

DI void phase_n(const Params& P, int hb) {
    const int tid = get_tid(); const int lane = tid & 63, wid = tid >> 6;
    const float* mod = (const float*)(P.ws + WS_MOD);
    u16* Hh = (u16*)(P.ws + WS_HH);
    for (int row = blockIdx.x * NWAVE + wid; row < HT; row += gridDim.x * NWAVE) {
        const int grow = hb * HT + row; const int b = grow / SEQ;
        const f32x4* xr = (const f32x4*)(P.x + (size_t)grow * DM);
        f32x4 v[4]; float ss = 0.f;
#pragma unroll
        for (int j = 0; j < 4; ++j) { v[j] = xr[lane + 64 * j]; ss += v[j].x * v[j].x + v[j].y * v[j].y + v[j].z * v[j].z + v[j].w * v[j].w; }
        const float rstd = rsqrtf(wave_sum(ss) * (1.f / DM) + EPS);
        const f32x4* g = (const f32x4*)(P.g_pre);
        const f32x4* sh = (const f32x4*)(mod + (0 * 4 + b) * 3072);
        const f32x4* sc = (const f32x4*)(mod + (0 * 4 + b) * 3072 + 1024);
        u32x2* o8 = (u32x2*)(Hh + (size_t)row * DM);
#pragma unroll
        for (int j = 0; j < 4; ++j) {
            const int c4 = lane + 64 * j; f32x4 gg = g[c4], s1 = sc[c4], s0 = sh[c4];
            float h0 = v[j].x * rstd * gg.x * (1.f + s1.x) + s0.x, h1 = v[j].y * rstd * gg.y * (1.f + s1.y) + s0.y;
            float h2 = v[j].z * rstd * gg.z * (1.f + s1.z) + s0.z, h3 = v[j].w * rstd * gg.w * (1.f + s1.w) + s0.w;
            u32x2 o = {pk2(h0, h1), pk2(h2, h3)}; o8[c4] = o;
        }
    }
}

DI void phase_f(const Params& P, int hb, int l) {
    const int tid = get_tid(); const int lane = tid & 63, wid = tid >> 6;
    const float* mod = (const float*)(P.ws + WS_MOD);
    u16* Hh = (u16*)(P.ws + WS_HH);
    const u16* Y2 = (const u16*)(P.ws + WS_Y2);
    const float* xin_base = l == 0 ? P.x : P.out;
    for (int row = blockIdx.x * NWAVE + wid; row < HT; row += gridDim.x * NWAVE) {
        const int grow = hb * HT + row; const int b = grow / SEQ;
        const u32x2* yr = (const u32x2*)(Y2 + (size_t)row * DM);
        const f32x4* xr = (const f32x4*)(xin_base + (size_t)grow * DM);
        f32x4 v[4], xv[4]; float ss = 0.f;
#pragma unroll
        for (int j = 0; j < 4; ++j) { const u32x2 yy = yr[lane + 64 * j]; v[j].x = bflo(yy.x); v[j].y = bfhi(yy.x); v[j].z = bflo(yy.y); v[j].w = bfhi(yy.y);
            xv[j] = xr[lane + 64 * j]; ss += v[j].x * v[j].x + v[j].y * v[j].y + v[j].z * v[j].z + v[j].w * v[j].w; }
        const float rstd = rsqrtf(wave_sum(ss) * (1.f / DM) + EPS);
        const f32x4* g = (const f32x4*)(P.g_post + l * DM);
        const f32x4* gt = (const f32x4*)(mod + (l * 4 + b) * 3072 + 2048);
        f32x4* orow = (f32x4*)(P.out + (size_t)grow * DM);
        float ss2 = 0.f;
#pragma unroll
        for (int j = 0; j < 4; ++j) {
            const int c4 = lane + 64 * j; f32x4 gg = g[c4], ga = gt[c4];
            xv[j].x += ga.x * (v[j].x * rstd * gg.x); xv[j].y += ga.y * (v[j].y * rstd * gg.y);
            xv[j].z += ga.z * (v[j].z * rstd * gg.z); xv[j].w += ga.w * (v[j].w * rstd * gg.w);
            orow[c4] = xv[j];
            ss2 += xv[j].x * xv[j].x + xv[j].y * xv[j].y + xv[j].z * xv[j].z + xv[j].w * xv[j].w;
        }
        if (l == 0) {
            const float rstd2 = rsqrtf(wave_sum(ss2) * (1.f / DM) + EPS);
            const f32x4* g1 = (const f32x4*)(P.g_pre + DM);
            const f32x4* sh = (const f32x4*)(mod + (1 * 4 + b) * 3072);
            const f32x4* sc = (const f32x4*)(mod + (1 * 4 + b) * 3072 + 1024);
            u32x2* o8 = (u32x2*)(Hh + (size_t)row * DM);
#pragma unroll
            for (int j = 0; j < 4; ++j) {
                const int c4 = lane + 64 * j; f32x4 gg = g1[c4], s1 = sc[c4], s0 = sh[c4];
                float h0 = xv[j].x * rstd2 * gg.x * (1.f + s1.x) + s0.x, h1 = xv[j].y * rstd2 * gg.y * (1.f + s1.y) + s0.y;
                float h2 = xv[j].z * rstd2 * gg.z * (1.f + s1.z) + s0.z, h3 = xv[j].w * rstd2 * gg.w * (1.f + s1.w) + s0.w;
                u32x2 o = {pk2(h0, h1), pk2(h2, h3)}; o8[c4] = o;
            }
        }
    }
}

DI void glds16(const void* g, unsigned lds_base) {
    unsigned sv; asm volatile("s_mov_b32 %0, m0\n\ts_mov_b32 m0, %2\n\ts_nop 0\n\tglobal_load_lds_dwordx4 %1, off\n\ts_mov_b32 m0, %0" : "=&s"(sv) : "v"(g), "s"(lds_base) : "memory"); }
namespace pg8 {
constexpr int BM = 256, BK = 64, HALF = 128, HTB = HALF * BK * 2  ;
DI int lds_byte(int r, int c) { const int st = (r >> 4) * 2 + (c >> 5), rr = r & 15, cc = c & 31, ob = rr * 64 + cc * 2; return st * 1024 + (ob ^ (((ob >> 9) & 1) << 5)); }
DI void stage_rc(int b, int& R, int& C) { const int st = b / 1024, sb = b % 1024, swz = sb ^ (((sb >> 9) & 1) << 5); R = (st >> 1) * 16 + swz / 64; C = (st & 1) * 32 + (swz % 64) / 2; }
DI int perm32(int rho) { const int n = rho >> 4, i = rho & 15; return 8 * (i >> 2) + 4 * n + (i & 3); }
struct Unit { int pm, pn; };
DI bool next_unit(int i, int nunits, Unit& u) {
    const int L = i * (int)gridDim.x + (int)blockIdx.x; if (L >= nunits) return false;
    const int i2 = L >> 8, b = L & 255, x = b & 7, j = b >> 3; u.pm = 8 * x + (j & 7); u.pn = 4 * i2 + (j >> 3); return true;
}
template <bool REMAP>
DI void gemm_phase(LAS unsigned char* lds, const u16* A, int lda, const u16* Bt, int K, u16* O, int ldc, int nunits) {
    const int tid = get_tid(), wid = __builtin_amdgcn_readfirstlane(tid >> 6), lane = tid & 63, wr = wid >> 2, wc = wid & 3, fr = lane & 15, fq = lane >> 4;
    const int nt = K / BK;
    unsigned voffA[2], voffB[2];
#pragma unroll
    for (int i = 0; i < 2; ++i) { int R, C; stage_rc(tid * 16 + i * 8192, R, C); const int Rb = (R & ~31) + perm32(R & 31);
        voffA[i] = (unsigned)(R * lda + C) * 2u; voffB[i] = (unsigned)(Rb * K + C) * 2u; }
    const size_t kstep = (size_t)(BK * 2);
    const size_t hstepA = (size_t)HALF * lda * 2, hstepB = (size_t)HALF * K * 2;
    const size_t tstepA = 2 * hstepA, tstepB = 2 * hstepB;
    auto akb = [&](int kt) -> size_t { const int k0 = kt * BK; return (size_t)(REMAP ? (k0 < 768 ? k0 : (k0 < 1536 ? k0 + 384 : k0 + 1920)) : k0) * 2; };
    const unsigned ldsw = (unsigned)wid * 1024u;
    const int aoff = lds_byte(wr * 64 + fr, fq * 8), boff = lds_byte(wc * 32 + fr, fq * 8);
#define PG8_SA(b, h) (((b) * 2 + (h)) * HTB)
#define PG8_SB(b, h) ((4 + (b) * 2 + (h)) * HTB)
#define PG8_STAGE(bufoff, gbase, voff) do { _Pragma("unroll") for (int _i = 0; _i < 2; ++_i) \
        __builtin_amdgcn_global_load_lds((const unsigned*)((const char*)(gbase) + (voff)[_i]), (LAS unsigned*)(lds + (bufoff) + ldsw + _i * 8192), 16, 0, 0); } while (0)
#define PG8_LDA(dst, b, h) do { _Pragma("unroll") for (int m = 0; m < 4; ++m) _Pragma("unroll") for (int k = 0; k < 2; ++k) dst[m][k] = *(const LAS bf16x8*)(lds + PG8_SA(b, h) + aoff + m * 2048 + k * 1024); } while (0)
#define PG8_LDB(dst, b, h) do { _Pragma("unroll") for (int n = 0; n < 2; ++n) _Pragma("unroll") for (int k = 0; k < 2; ++k) dst[n][k] = *(const LAS bf16x8*)(lds + PG8_SB(b, h) + boff + n * 2048 + k * 1024); } while (0)
#define PG8_MMA(ai, bj, At, Bt_) do { __builtin_amdgcn_s_setprio(1); _Pragma("unroll") for (int m = 0; m < 4; ++m) _Pragma("unroll") for (int n = 0; n < 2; ++n) _Pragma("unroll") for (int k = 0; k < 2; ++k) \
        acc[ai][bj][m][n] = __builtin_amdgcn_mfma_f32_16x16x32_bf16(Bt_[n][k], At[m][k], acc[ai][bj][m][n], 0, 0, 0); __builtin_amdgcn_s_setprio(0); } while (0)
#define PG8_WAIT_V(n) asm volatile("s_waitcnt vmcnt(" #n ")" ::: "memory")
#define PG8_WAIT_L(n) asm volatile("s_waitcnt lgkmcnt(" #n ")" ::: "memory")
#define PG8_BAR __builtin_amdgcn_s_barrier()
#define PG8_SCHED __builtin_amdgcn_sched_barrier(0)
    Unit cur, nxt; int ui = 0;
    if (!next_unit(0, nunits, cur)) return;
    f32x4 acc[2][2][4][2];
#pragma unroll
    for (int a = 0; a < 2; ++a)
#pragma unroll
        for (int b = 0; b < 2; ++b)
#pragma unroll
            for (int m = 0; m < 4; ++m)
#pragma unroll
                for (int n = 0; n < 2; ++n) acc[a][b][m][n] = (f32x4){0.f, 0.f, 0.f, 0.f};
    bf16x8 At[4][2], B0[2][2], B1[2][2];
    const char* cA = (const char*)A + (size_t)cur.pm * tstepA; const char* cB = (const char*)Bt + (size_t)cur.pn * tstepB;
    PG8_STAGE(PG8_SB(0, 0), cB, voffB); PG8_STAGE(PG8_SA(0, 0), cA + akb(0), voffA); PG8_STAGE(PG8_SB(0, 1), cB + hstepB, voffB); PG8_STAGE(PG8_SA(0, 1), cA + akb(0) + hstepA, voffA);
    if (wr == 1) PG8_BAR;
    PG8_WAIT_V(4); PG8_BAR;
    PG8_STAGE(PG8_SB(1, 0), cB + kstep, voffB); PG8_STAGE(PG8_SA(1, 0), cA + akb(1), voffA); PG8_STAGE(PG8_SB(1, 1), cB + hstepB + kstep, voffB);
    PG8_WAIT_V(6); PG8_BAR;
    for (;;) {
        const bool has_next = next_unit(ui + 1, nunits, nxt);
        const char* nA = has_next ? (const char*)A + (size_t)nxt.pm * tstepA : cA; const char* nB = has_next ? (const char*)Bt + (size_t)nxt.pn * tstepB : cB;
        for (int t = 0; t < nt; t += 2) {
            const bool last = (t == nt - 2);
            const char* a1 = cA + akb(t + 1);
            const char* a2 = last ? nA + akb(0) : cA + akb(t + 2); const char* b2 = last ? nB : cB + (size_t)(t + 2) * kstep;
            const char* a3 = last ? nA + akb(1) : cA + akb(t + 3); const char* b3 = b2 + kstep;
            PG8_LDB(B0, 0, 0); PG8_SCHED; PG8_LDA(At, 0, 0); PG8_STAGE(PG8_SA(1, 1), a1 + hstepA, voffA);
            PG8_WAIT_L(8); PG8_BAR; PG8_WAIT_L(0); PG8_MMA(0, 0, At, B0); PG8_BAR; PG8_SCHED;
            PG8_LDB(B1, 0, 1); PG8_STAGE(PG8_SB(0, 0), b2, voffB);
            PG8_BAR; PG8_WAIT_L(0); PG8_MMA(0, 1, At, B1); PG8_BAR;
            PG8_LDA(At, 0, 1); PG8_STAGE(PG8_SA(0, 0), a2, voffA);
            PG8_BAR; PG8_WAIT_L(0); PG8_MMA(1, 0, At, B0); PG8_BAR; PG8_SCHED;
            PG8_STAGE(PG8_SB(0, 1), b2 + hstepB, voffB);
            PG8_WAIT_V(6); PG8_BAR; PG8_MMA(1, 1, At, B1); PG8_BAR;
            PG8_LDB(B0, 1, 0); PG8_SCHED; PG8_LDA(At, 1, 0); PG8_STAGE(PG8_SA(0, 1), a2 + hstepA, voffA);
            PG8_WAIT_L(8); PG8_BAR; PG8_WAIT_L(0); PG8_MMA(0, 0, At, B0); PG8_BAR; PG8_SCHED;
            PG8_LDB(B1, 1, 1); PG8_STAGE(PG8_SB(1, 0), b3, voffB);
            PG8_BAR; PG8_WAIT_L(0); PG8_MMA(0, 1, At, B1); PG8_BAR;
            PG8_LDA(At, 1, 1); PG8_STAGE(PG8_SA(1, 0), a3, voffA);
            PG8_BAR; PG8_WAIT_L(0); PG8_MMA(1, 0, At, B0); PG8_BAR; PG8_SCHED;
            PG8_STAGE(PG8_SB(1, 1), b3 + hstepB, voffB);
            PG8_WAIT_V(6); PG8_BAR; PG8_MMA(1, 1, At, B1); PG8_BAR;
        }
        {
            const int row0 = cur.pm * BM + wr * 64 + fr, col0 = cur.pn * BM + wc * 32 + 8 * fq;
#pragma unroll
            for (int ai = 0; ai < 2; ++ai)
#pragma unroll
                for (int m = 0; m < 4; ++m) { u16* rowp = O + (size_t)(row0 + ai * HALF + m * 16) * ldc + col0;
#pragma unroll
                    for (int bj = 0; bj < 2; ++bj) { const f32x4 v0 = acc[ai][bj][m][0], v1 = acc[ai][bj][m][1];
                        u32x4 w = {pk2(v0[0], v0[1]), pk2(v0[2], v0[3]), pk2(v1[0], v1[1]), pk2(v1[2], v1[3])};
                        *(u32x4*)(rowp + bj * HALF) = w; } }
        }
        if (!has_next) break;
#pragma unroll
        for (int a = 0; a < 2; ++a)
#pragma unroll
            for (int b = 0; b < 2; ++b)
#pragma unroll
                for (int m = 0; m < 4; ++m)
#pragma unroll
                    for (int n = 0; n < 2; ++n) acc[a][b][m][n] = (f32x4){0.f, 0.f, 0.f, 0.f};
        cur = nxt; cA = nA; cB = nB; ++ui;
    }
    PG8_WAIT_V(0);
    if (wr == 0) PG8_BAR;
    PG8_BAR;
#undef PG8_SA
#undef PG8_SB
#undef PG8_STAGE
#undef PG8_LDA
#undef PG8_LDB
#undef PG8_MMA
#undef PG8_WAIT_V
#undef PG8_WAIT_L
#undef PG8_BAR
#undef PG8_SCHED
}
}

DI void phase_g1(const Params& P, char* lds, int l) {
    const u16* A = (const u16*)(P.ws + WS_HH);
    const u16* Bt = (const u16*)(P.ws + WS_WIN) + (size_t)l * 7168 * 1024;
    pg8::gemm_phase<false>((LAS unsigned char*)lds, A, DM, Bt, 1024, (u16*)(P.ws + WS_PH), PO, 64 * 28);
}
DI void phase_g2(const Params& P, char* lds, int l) {
    const u16* A = (const u16*)(P.ws + WS_PH);
    const u16* Bt = (const u16*)(P.ws + WS_WOUT) + (size_t)l * 1024 * 2048;
    pg8::gemm_phase<true>((LAS unsigned char*)lds, A, PO, Bt, 2048, (u16*)(P.ws + WS_Y2), DM, 64 * 4);
}

constexpr int GP = 144;
#define ROWMAX32(mx)                                                                                                                   \
    {   float a_ = amax3(p0[0], p0[1], p1[0]), b_ = amax3(p0[2], p0[3], p1[1]);                                                       \
        a_ = amax3(a_, p1[2], p1[3]);                                                                                                 \
        _Pragma("unroll") for (int i = 4; i < 16; i += 4) { a_ = amax3(a_, p0[i], p0[i + 1]); b_ = amax3(b_, p0[i + 2], p0[i + 3]); a_ = amax3(a_, p1[i], p1[i + 1]); b_ = amax3(b_, p1[i + 2], p1[i + 3]); } \
        mx = fmaxf(a_, b_); }
#define ATTN_TAIL(DVT, VADDR)                                                                                                         \
    bf16x8 vf[2][DVT];                                                                                                                \
    _Pragma("unroll") for (int dt = 0; dt < DVT; ++dt) { s16x4 lo = vtr(VADDR(0, dt, 0)), hi = vtr(VADDR(0, dt, 1));                  \
        vf[0][dt] = __builtin_shufflevector(lo, hi, 0, 1, 2, 3, 4, 5, 6, 7); }                                                        \
    __builtin_amdgcn_sched_barrier(0);                                                                                                \
    float mn, ls; const float m_old = m; const float sc2v = SC2;                                                                      \
    if (far) {          \
        float mx;                                                                                                                     \
        __builtin_amdgcn_sched_barrier(0);                                                                                            \
        asm volatile("s_nop 7\n\ts_nop 7\n\ts_nop 3" ::: "memory");             \
        __builtin_amdgcn_sched_barrier(0);                                                                                            \
        ROWMAX32(mx)                                                                                                                  \
        mx = fmaf(xhalf_max(mx), SC2, cfar);                                                                                          \
        mn = fmaxf(m, mx);                                                                                                            \
        const float cb = cfar - mn;                                                                                                   \
        __builtin_amdgcn_sched_barrier(0);                                                                                            \
        _Pragma("unroll") for (int i = 0; i < 16; ++i) { p0[i] = afma(p0[i], sc2v, cb); p1[i] = afma(p1[i], sc2v, cb); }              \
    } else {                                                                                                                          \
        float bb0[16], bb1[16];                                                                                                       \
        _Pragma("unroll") for (int i = 0; i < 16; ++i) { const int c = (i & 3) + 8 * (i >> 2); bb0[i] = tb[63 - c]; bb1[i] = tb[31 - c]; } \
        __builtin_amdgcn_sched_barrier(0);                                                                                            \
        asm volatile("s_nop 7\n\ts_nop 7\n\ts_nop 3" ::: "memory");             \
        __builtin_amdgcn_sched_barrier(0);                                                                                            \
        _Pragma("unroll") for (int i = 0; i < 16; ++i) { p0[i] = afma(p0[i], sc2v, bb0[i]); p1[i] = afma(p1[i], sc2v, bb1[i]); }      \
        float mx;                                                                                                                     \
        ROWMAX32(mx)                                                                                                                  \
        mx = xhalf_max(mx);                                                                                                           \
        mn = fmaxf(m, mx);                                                                                                            \
        _Pragma("unroll") for (int i = 0; i < 16; ++i) { p0[i] = asub(p0[i], mn); p1[i] = asub(p1[i], mn); }                          \
    }                                                                                                                                 \
    _Pragma("unroll") for (int i = 0; i < 16; ++i) { p0[i] = __builtin_amdgcn_exp2f(p0[i]); p1[i] = __builtin_amdgcn_exp2f(p1[i]); }  \
    __builtin_amdgcn_sched_barrier(0);                                                                                                \
    asm volatile("s_nop 1" ::: "memory");                                                  \
    {   float t8[8];                                                                                                                  \
        _Pragma("unroll") for (int i = 0; i < 8; ++i) t8[i] = aadd(aadd(p0[i], p1[i]), aadd(p0[i + 8], p1[i + 8]));                   \
        ls = aadd(aadd(aadd(t8[0], t8[1]), aadd(t8[2], t8[3])), aadd(aadd(t8[4], t8[5]), aadd(t8[6], t8[7])));                        \
    }                                                                                                                                 \
    m = mn;                                                                                                                           \
    if (__builtin_amdgcn_ballot_w64(mn != m_old) != 0ull) {           \
        const float alpha = __builtin_amdgcn_exp2f(m_old - mn);                                                                       \
        l *= alpha;                                                                                                                   \
        _Pragma("unroll") for (int dt = 0; dt < DVT; ++dt)                                                                            \
            _Pragma("unroll") for (int i = 0; i < 16; ++i) O[dt][i] *= alpha;                                                         \
    }                                                                                                                                 \
    l += ls;                                                                                                                          \
    _Pragma("unroll") for (int g = 0; g < 4; ++g) {                                                                                   \
        if (g < 3) {                                                                                                                  \
            _Pragma("unroll") for (int dt = 0; dt < DVT; ++dt) { s16x4 lo = vtr(VADDR(g + 1, dt, 0)), hi = vtr(VADDR(g + 1, dt, 1));  \
                vf[(g + 1) & 1][dt] = __builtin_shufflevector(lo, hi, 0, 1, 2, 3, 4, 5, 6, 7); }                                      \
        }                                                                                                                             \
        u32x4 pw; const int s2 = g & 1;                                                                                               \
        if (g < 2) { pw[0] = pk2(p0[8 * s2 + 0], p0[8 * s2 + 1]); pw[1] = pk2(p0[8 * s2 + 2], p0[8 * s2 + 3]); pw[2] = pk2(p0[8 * s2 + 4], p0[8 * s2 + 5]); pw[3] = pk2(p0[8 * s2 + 6], p0[8 * s2 + 7]); } \
        else { pw[0] = pk2(p1[8 * s2 + 0], p1[8 * s2 + 1]); pw[1] = pk2(p1[8 * s2 + 2], p1[8 * s2 + 3]); pw[2] = pk2(p1[8 * s2 + 4], p1[8 * s2 + 5]); pw[3] = pk2(p1[8 * s2 + 6], p1[8 * s2 + 7]); }        \
        const bf16x8 pf = __builtin_bit_cast(bf16x8, pw);                                                                             \
        __builtin_amdgcn_sched_barrier(0);                                                                                            \
        _Pragma("unroll") for (int dt = 0; dt < DVT; ++dt) O[dt] = MFMA(vf[g & 1][dt], pf, O[dt]);                                    \
        __builtin_amdgcn_sched_barrier(0);                                                                                            \
    }

template <int DVT>
DI void attn_step(lptr sKw, int kpitch, lptr sV, int vpitch, const bf16x8 (&qf)[4], float& m, float& l, f32x16 (&O)[DVT],
                  const LAS float* tb, bool far, float cfar, int lane) {
    const int r = lane & 31, h = lane >> 5;
    f32x16 p0, p1;
#pragma unroll
    for (int i = 0; i < 16; ++i) { p0[i] = 0.f; p1[i] = 0.f; }
    bf16x8 kf[8];
#pragma unroll
    for (int s = 0; s < 4; ++s) {
        kf[2 * s] = *(const LAS bf16x8*)(sKw + r * kpitch + (16 * s + 8 * h) * 2);
        kf[2 * s + 1] = *(const LAS bf16x8*)(sKw + (32 + r) * kpitch + (16 * s + 8 * h) * 2);
    }
    __builtin_amdgcn_sched_barrier(0);
#pragma unroll
    for (int s = 0; s < 4; ++s) { p0 = MFMA(kf[2 * s], qf[s], p0); p1 = MFMA(kf[2 * s + 1], qf[s], p1); }
    const int i16 = lane & 15, q = i16 >> 2, pp = i16 & 3, blk = (lane >> 4) & 1;
    lptr vb = sV + (4 * h + q) * vpitch + (16 * blk + 4 * pp) * 2;
#define VADDR_PAD(g, dt, hi) (vb + (16 * (g) + 8 * (hi)) * vpitch + (dt) * 64)
    ATTN_TAIL(DVT, VADDR_PAD)
#undef VADDR_PAD
}

DI void band_item(const Params& P, char* lds_blk, int layer, int bp) {
    const int tid0 = get_tid(); const int half = tid0 >> 8, tid = tid0 & 255, lane = tid & 63, w = tid >> 6, r = lane & 31, h = lane >> 5;
    char* lds = lds_blk + half * 40960;
    const int type = bp / 768, rem = bp % 768; const int bl = rem / 384, head = 2 * ((rem % 384) / 64) + half, blk = rem % 64;
    const int dil = type <= 1 ? 1 : (type == 2 ? 4 : 16);
    const int nper = 64 / dil; const int residue = blk / nper, nb = blk % nper;
    u16* Ph = (u16*)(P.ws + WS_PH);
    const size_t rs = (size_t)dil * PO;
    const size_t base_row = (size_t)bl * SEQ + residue + (size_t)dil * 128 * nb;
    int qcol, kcol, vcol;
    if (type == 0) { qcol = OFF_AQ + head * 64; kcol = OFF_AK + (head >> 2) * 64; vcol = OFF_AV + (head >> 2) * 64; }
    else { qcol = OFF_BQ + head * 64; kcol = OFF_BK + head * 64; vcol = OFF_BV + head * 64; }
    const u16* qp = Ph + base_row * PO + qcol;
    const u16* kp = Ph + base_row * PO + kcol;
    const u16* vp = Ph + base_row * PO + vcol;
    float* btab = (float*)(lds + 4 * 64 * GP);
    const float* tabg = (const float*)(P.ws + WS_TABB) + (type * 12 + head) * 384;
    for (int i = tid; i < 384; i += 256) btab[i] = tabg[i];
    bf16x8 qf[4];
#pragma unroll
    for (int s = 0; s < 4; ++s) qf[s] = *(const bf16x8*)(qp + (size_t)(32 * w + r) * rs + 16 * s + 8 * h);
    float m = -1e30f, l = 0.f;
    if (type == 0) { m = P.sinks[layer * 12 + head] * LOG2E; l = (h == 0) ? 1.f : 0.f; }
    f32x16 O[2];
#pragma unroll
    for (int dt = 0; dt < 2; ++dt)
#pragma unroll
        for (int i = 0; i < 16; ++i) O[dt][i] = 0.f;
    const int maxd = type == 0 ? 127 : 128;
    const int qpos = 128 + 32 * w + r;
    const int kt0 = (nb == 0 ? 2 : 0);
    u32x4 rk[2], rv[2];
    const int srow = tid >> 3, sch = tid & 7;
    auto gload = [&](int kt) {
#pragma unroll
        for (int j = 0; j < 2; ++j) {
            const ptrdiff_t ro = ((ptrdiff_t)(64 * kt + srow + 32 * j) - 128) * (ptrdiff_t)rs + sch * 8;
            rk[j] = *(const u32x4*)(kp + ro); rv[j] = *(const u32x4*)(vp + ro);
        }
    };
    auto lstore = [&](int b) {
        char* sK = lds + b * (2 * 64 * GP); char* sV = sK + 64 * GP;
#pragma unroll
        for (int j = 0; j < 2; ++j) { *(u32x4*)(sK + (srow + 32 * j) * GP + sch * 16) = rk[j]; *(u32x4*)(sV + (srow + 32 * j) * GP + sch * 16) = rv[j]; }
    };
    gload(kt0); lstore(0);
    for (int kt = kt0; kt < 4; ++kt) {
        if (kt + 1 < 4) gload(kt + 1);
        __syncthreads();
        const int b = (kt - kt0) & 1;
        const bool active = (64 * kt <= 128 + 32 * w + 31) && (64 * kt + 63 >= 128 + 32 * w - maxd);
        if (active) {
            const LAS float* tb = (const LAS float*)btab + (qpos - 64 * kt - 4 * h + 128 - 63);
            lptr sK = (lptr)lds + b * (2 * 64 * GP);
            attn_step<2>(sK, GP, sK + 64 * GP, GP, qf, m, l, O, tb, false, 0.f, lane);
        }
        if (kt + 1 < 4) lstore(b ^ 1);
    }
    __syncthreads();
    const float ltot = xhalf_sum(l);
    const float inv = 1.f / ltot;
    constexpr int OP = 272;
    char* sO = lds + w * (32 * OP);
#pragma unroll
    for (int dt = 0; dt < 2; ++dt)
#pragma unroll
        for (int g = 0; g < 4; ++g) {
            f32x4 o4 = {O[dt][4 * g + 0] * inv, O[dt][4 * g + 1] * inv, O[dt][4 * g + 2] * inv, O[dt][4 * g + 3] * inv};
            *(f32x4*)(sO + r * OP + (32 * dt + 8 * g + 4 * h) * 4) = o4;
        }
    if (type != 0 && h == 0) ((float*)(P.ws + WS_PBL))[((size_t)(type - 1) * HT + base_row + (size_t)(32 * w + r) * dil) * 12 + head] = (m + __builtin_amdgcn_logf(ltot)) * LN2;
    const int ch = lane & 7;
#pragma unroll
    for (int j = 0; j < 4; ++j) {
        const int rl = (lane >> 3) + 8 * j;
        const f32x4 a = *(const f32x4*)(sO + rl * OP + ch * 32), b = *(const f32x4*)(sO + rl * OP + ch * 32 + 16);
        const size_t orow = base_row + (size_t)(32 * w + rl) * dil;
        if (type == 0) {
            const u32x4 zz = *(const u32x4*)(Ph + orow * PO + OFF_Z + head * 64 + ch * 8);
            u32x4 o = {pk2(a.x * silu_f(bflo(zz.x)), a.y * silu_f(bfhi(zz.x))), pk2(a.z * silu_f(bflo(zz.y)), a.w * silu_f(bfhi(zz.y))),
                       pk2(b.x * silu_f(bflo(zz.z)), b.y * silu_f(bfhi(zz.z))), pk2(b.z * silu_f(bflo(zz.w)), b.w * silu_f(bfhi(zz.w)))};
            *(u32x4*)(Ph + orow * PO + OFF_AQ + head * 64 + ch * 8) = o;
        } else {
            u32x4 o = {pk2(a.x, a.y), pk2(a.z, a.w), pk2(b.x, b.y), pk2(b.z, b.w)};
            *(u32x4*)((u16*)(P.ws + WS_PBO) + ((size_t)(type - 1) * HT + orow) * 768 + head * 64 + ch * 8) = o;
        }
    }
}

template <typename F>
DI void diff_step(lptr sK, lptr sV, int kx0, int vl0, const bf16x8 (&qf)[4], float& m, float& l, f32x16 (&O)[4],
                  const LAS float* tb, bool far, float cfar, int lane, F&& mid) {
    const int r = lane & 31;
    f32x16 p0, p1;
#pragma unroll
    for (int i = 0; i < 16; ++i) { p0[i] = 0.f; p1[i] = 0.f; }
    lptr kr = sK + r * 256;
    bf16x8 kf[8];
#pragma unroll
    for (int s = 0; s < 4; ++s) {
        const int co = (kx0 ^ (2 * s)) * 16;
        kf[2 * s] = *(const LAS bf16x8*)(kr + co);
        kf[2 * s + 1] = *(const LAS bf16x8*)(kr + 8192 + co);
    }
    __builtin_amdgcn_sched_barrier(0);
    mid();
    __builtin_amdgcn_sched_barrier(0);
#pragma unroll
    for (int s = 0; s < 4; ++s) { p0 = MFMA(kf[2 * s], qf[s], p0); p1 = MFMA(kf[2 * s + 1], qf[s], p1); }
#define VADDR_SWZ(g, dt, hi) (sV + (vl0 ^ (((dt) << 6) | ((hi) << 5))) + (16 * (g) + 8 * (hi)) * 256)
    ATTN_TAIL(4, VADDR_SWZ)
#undef VADDR_SWZ
}

DI void diff_item(const Params& P, char* lds, int layer, int pair, int qt, int& tab_head) {
    const int tid = get_tid(), lane = tid & 63, w = tid >> 6, r = lane & 31, hh = lane >> 5;
    const int bl = pair >> 2, head = pair & 3;
    const int mp = w >> 2, qs = w & 3;
    u16* Ph = (u16*)(P.ws + WS_PH);
    u16* base = Ph + (size_t)bl * SEQ * PO;
    const int q0 = 128 * qt;
    const int qpos = q0 + 32 * qs + r;
    float* ctab = (float*)(lds + LDS_CTAB);
    const float* tabg = (const float*)(P.ws + WS_TABC) + head * 2112;
    if (tab_head != head) { for (int i = tid; i < 2112; i += NTHR) ctab[i] = tabg[i]; tab_head = head; }
    const float cfar = tabg[2111];
    const unsigned lds0 = (unsigned)(uintptr_t)lds;
    int goff[2];
#pragma unroll
    for (int i = 0; i < 2; ++i) goff[i] = (8 * w + 4 * i + (lane >> 4)) * PO + (((lane & 15) ^ (((lane >> 4) << 2) | ((2 * w + i) & 3))) * 8);
    const u16* kg = base + head * 128 + OFF_CK;
    const u16* vg = base + head * 128 + OFF_CV;
    auto issue = [&](int kt, int buf) {
        const size_t to = (size_t)(64 * kt) * PO;
#pragma unroll
        for (int i = 0; i < 2; ++i) {
            glds16(kg + to + goff[i], (unsigned)__builtin_amdgcn_readfirstlane(lds0 + buf * 32768 + (2 * w + i) * 1024));
            glds16(vg + to + goff[i], (unsigned)__builtin_amdgcn_readfirstlane(lds0 + buf * 32768 + 16384 + (2 * w + i) * 1024));
        }
    };
    issue(0, 0);
    bf16x8 qf[4];
#pragma unroll
    for (int s = 0; s < 4; ++s) qf[s] = *(const bf16x8*)(base + (size_t)qpos * PO + OFF_CQ + head * 128 + mp * 64 + 16 * s + 8 * hh);
    float m = -1e30f, l = 0.f;
    f32x16 O[4];
#pragma unroll
    for (int dt = 0; dt < 4; ++dt)
#pragma unroll
        for (int i = 0; i < 16; ++i) O[dt][i] = 0.f;
    const int sig_r = ((r & 3) << 2) | ((r >> 2) & 3);
    const int kx0 = (8 * mp + hh) ^ sig_r;
    const int i16 = lane & 15, q = i16 >> 2, pp = i16 & 3, blk = (lane >> 4) & 1;
    const int vl0 = (4 * hh + q) * 256 + (16 * ((q << 2) | (blk << 1) | ((pp >> 1) ^ hh)) + 8 * (pp & 1));
    const int nkt = 2 * qt + 2;
    for (int kt = 0; kt < nkt; ++kt) {
        asm volatile("s_waitcnt vmcnt(0)" ::: "memory");
        __syncthreads();
        auto mid = [&]() { if (kt + 1 < nkt) issue(kt + 1, (kt + 1) & 1); };
        if (64 * kt <= q0 + 32 * qs + 31) {
            const int dmin = (q0 + 32 * qs) - (64 * kt + 63);
            bool far = dmin >= 1536; float cf = cfar;
            if (!far && dmin >= 256) {
                const float c1 = ctab[dmin + 64], c2 = ctab[dmin + 94 + 64];
                if (__builtin_amdgcn_readfirstlane(__float_as_uint(c1)) == __builtin_amdgcn_readfirstlane(__float_as_uint(c2))) { far = true; cf = c1; }
            }
            const LAS float* tb = (const LAS float*)ctab + (qpos - 64 * kt - 4 * hh + 64 - 63);
            lptr bufp = (lptr)lds + (kt & 1) * 32768;
            diff_step(bufp, bufp + 16384, kx0, vl0, qf, m, l, O, tb, far, cf, lane, mid);
        } else mid();
    }
    __syncthreads();
    const float inv = 1.f / xhalf_sum(l);
    float* cmb = (float*)lds;
    if (mp == 1) {
#pragma unroll
        for (int dt = 0; dt < 4; ++dt)
#pragma unroll
            for (int i = 0; i < 16; ++i) cmb[(qs * 128 + 32 * dt + (i & 3) + 8 * (i >> 2) + 4 * hh) * 32 + r] = O[dt][i] * inv;
    }
    __syncthreads();
    if (mp == 0) {
        const float lam = ((const float*)(P.ws + WS_LAM))[layer];
        const float lam_init = 0.8f - 0.6f * expf(-0.3f * (float)layer);
        float ss = 0.f;
#pragma unroll
        for (int dt = 0; dt < 4; ++dt)
#pragma unroll
            for (int i = 0; i < 16; ++i) {
                float o = O[dt][i] * inv - lam * cmb[(qs * 128 + 32 * dt + (i & 3) + 8 * (i >> 2) + 4 * hh) * 32 + r];
                O[dt][i] = o; ss += o * o;
            }
        ss = xhalf_sum(ss);
        const float rstd = rsqrtf(ss * (1.f / 128.f) + EPS) * (1.f - lam_init);
        const float* gs = P.g_sub + layer * 128;
        u16* orow = base + (size_t)qpos * PO;
#pragma unroll
        for (int dt = 0; dt < 4; ++dt)
#pragma unroll
            for (int g = 0; g < 4; ++g) {
                const int d = 32 * dt + 8 * g + 4 * hh;
                u32x2 zz = *(const u32x2*)(orow + OFF_Z + 1536 + head * 128 + d);
                f32x4 gg = *(const f32x4*)(gs + d);
                float y0 = O[dt][4 * g + 0] * rstd * gg.x * silu_f(bflo(zz.x)), y1 = O[dt][4 * g + 1] * rstd * gg.y * silu_f(bfhi(zz.x));
                float y2 = O[dt][4 * g + 2] * rstd * gg.z * silu_f(bflo(zz.y)), y3 = O[dt][4 * g + 3] * rstd * gg.w * silu_f(bfhi(zz.y));
                u32x2 o = {pk2(y0, y1), pk2(y2, y3)};
                *(u32x2*)(orow + OFF_CQ + head * 128 + d) = o;
            }
    }
    __syncthreads();
}

DI void phase_att(const Params& P, char* lds, int hb, int layer) {
    unsigned* ctr = (unsigned*)(P.ws + WS_CTR) + (hb * 2 + layer) * 8;
    LAS int* slot = (LAS int*)(lds + LDS_SLOT);
    const int tid = get_tid();
    constexpr int NQ = 64 + 384;
    int tab_head = -1;
    for (int dq = 0; dq < 8; ++dq) {
        const int qx = (blockIdx.x + dq) & 7;
        while (true) {
            if (tid == 0) *slot = (int)atomicAdd(&ctr[qx], 1u);
            __syncthreads();
            const int qi = *slot;
            __syncthreads();
            if (qi >= NQ) break;
            if (qi < 64) diff_item(P, lds, layer, qx, 63 - qi, tab_head);
            else band_item(P, lds, layer, qx * 384 + (qi - 64));
        }
    }
}

DI void phase_cmb(const Params& P) {
    u16* Ph = (u16*)(P.ws + WS_PH);
    const u16* pbo = (const u16*)(P.ws + WS_PBO);
    const float* pbl = (const float*)(P.ws + WS_PBL);
    const int tid = get_tid();
    for (int idx = blockIdx.x * NTHR + tid; idx < HT * 96; idx += gridDim.x * NTHR) {
        const int row = idx / 96, c8 = idx % 96; const int head = c8 >> 3;
        float l0 = pbl[((size_t)0 * HT + row) * 12 + head], l1 = pbl[((size_t)1 * HT + row) * 12 + head], l2 = pbl[((size_t)2 * HT + row) * 12 + head];
        float mx = fmaxf(l0, fmaxf(l1, l2));
        float w0 = __expf(l0 - mx), w1 = __expf(l1 - mx), w2 = __expf(l2 - mx);
        const float inv = 1.f / (w0 + w1 + w2); w0 *= inv; w1 *= inv; w2 *= inv;
        u32x4 a = *(const u32x4*)(pbo + ((size_t)0 * HT + row) * 768 + c8 * 8);
        u32x4 b = *(const u32x4*)(pbo + ((size_t)1 * HT + row) * 768 + c8 * 8);
        u32x4 c = *(const u32x4*)(pbo + ((size_t)2 * HT + row) * 768 + c8 * 8);
        u32x4 z = *(const u32x4*)(Ph + (size_t)row * PO + OFF_Z + 768 + c8 * 8);
        u32x4 o;
#pragma unroll
        for (int j = 0; j < 4; ++j) {
            float lo = (w0 * bflo(a[j]) + w1 * bflo(b[j]) + w2 * bflo(c[j])) * silu_f(bflo(z[j]));
            float hi = (w0 * bfhi(a[j]) + w1 * bfhi(b[j]) + w2 * bfhi(c[j])) * silu_f(bfhi(z[j]));
            o[j] = pk2(lo, hi);
        }
        *(u32x4*)(Ph + (size_t)row * PO + OFF_BQ + c8 * 8) = o;
    }
}


#define XB_TMO      128
#define XB_XCNT(j)  (256  + 64 * (j))
#define XB_XSUB(j)  (1280 + 64 * (j))
#define XB_XGEN(j)  (2304 + 64 * (j))
#define XB_TOP      3328
#define XB_TOPGEN   3392
#define XCD_BAR_WORDS 3456
#define XB_SPIN_CAP (1u << 22)
DI unsigned xb_ld(unsigned* p)              { return __hip_atomic_load(p, __ATOMIC_RELAXED, __HIP_MEMORY_SCOPE_AGENT); }
DI unsigned xb_add(unsigned* p, unsigned v) { return __hip_atomic_fetch_add(p, v, __ATOMIC_RELAXED, __HIP_MEMORY_SCOPE_AGENT); }
DI unsigned xb_xcc_id() { return (unsigned)__builtin_amdgcn_s_getreg((3 << 11) | 20) & 0xFu; }
#define XB_SPIN(cond, bar) do { unsigned _sp = 0; while (cond) { __builtin_amdgcn_s_sleep(1); \
    if ((++_sp & 255u) == 0u) { if (xb_ld(&(bar)[XB_TMO])) break; if (_sp > XB_SPIN_CAP) { atomicAdd(&(bar)[XB_TMO], 1u); break; } } } } while (0)
struct XcdBarrier { unsigned* bar; unsigned x; volatile LAS unsigned* st; };
DI XcdBarrier xcd_barrier_post(unsigned* bar, volatile LAS unsigned* st) {
    XcdBarrier b; b.bar = bar; b.x = xb_xcc_id(); b.st = st;
    if (threadIdx.x == 0) (void)xb_add(&bar[XB_XCNT(b.x)], 1u);
    return b;
}
DI void xcd_barrier_complete(unsigned* bar, unsigned x, unsigned& nloc, unsigned& nx) {
    const unsigned G = gridDim.x * gridDim.y * gridDim.z;
    unsigned sum, cnt, mine, sp = 0u;
    for (;;) {
        sum = 0u; cnt = 0u; mine = 0u;
#pragma unroll
        for (unsigned j = 0; j < 16; ++j) { const unsigned c = xb_ld(&bar[XB_XCNT(j)]); sum += c; cnt += (c > 0u) ? 1u : 0u; mine = (j == x) ? c : mine; }
        if (sum == G) break;
        __builtin_amdgcn_s_sleep(1);
        if ((++sp & 255u) == 0u) { if (xb_ld(&bar[XB_TMO])) break; if (sp > XB_SPIN_CAP) { atomicAdd(&bar[XB_TMO], 1u); break; } }
    }
    nloc = mine > 0u ? mine : 1u; nx = cnt > 0u ? cnt : 1u;
}
DI void xcd_barrier(const XcdBarrier& b) {
    asm volatile("s_waitcnt vmcnt(0)" ::: "memory");
    __syncthreads();
    if (threadIdx.x == 0) {
        unsigned* bar = b.bar;
        __builtin_amdgcn_s_waitcnt(0);
        unsigned nloc = b.st[0], nx = b.st[1];
        if (nloc == 0u) { xcd_barrier_complete(bar, b.x, nloc, nx); b.st[0] = nloc; b.st[1] = nx; }
        const unsigned old = xb_add(&bar[XB_XSUB(b.x)], 1u);
        const unsigned gen = old / nloc;
        if (old + 1u == (gen + 1u) * nloc) {
            __builtin_amdgcn_fence(__ATOMIC_RELEASE, "agent");
            asm volatile("s_waitcnt vmcnt(0)" ::: "memory");
            const unsigned og = xb_add(&bar[XB_TOP], 1u);
            const unsigned tg = og / nx;
            if (og + 1u == (tg + 1u) * nx) xb_add(&bar[XB_TOPGEN], 1u);
            else XB_SPIN(xb_ld(&bar[XB_TOPGEN]) == tg, bar);
            __builtin_amdgcn_fence(__ATOMIC_ACQUIRE, "agent");
            xb_add(&bar[XB_XGEN(b.x)], 1u);
            asm volatile("s_waitcnt vmcnt(0)" ::: "memory");
        } else {
            XB_SPIN(xb_ld(&bar[XB_XGEN(b.x)]) == gen, bar);
            __builtin_amdgcn_fence(__ATOMIC_ACQUIRE, "agent");
            asm volatile("s_waitcnt vmcnt(0)" ::: "memory");
        }
    }
    __syncthreads();
}

#define LAUNDER(Q) Params Q = P; asm volatile("" : "+s"(Q.ws), "+s"(Q.out), "+s"(Q.x), "+s"(Q.rel), "+s"(Q.g_sub), "+s"(Q.sinks))
__global__ void __launch_bounds__(512, 1) mega(Params P) {
    extern __shared__ __attribute__((aligned(16))) char lds[];
    cg::grid_group grid = cg::this_grid();
    volatile LAS unsigned* xst = (volatile LAS unsigned*)(lds + LDS_XB);
    if (threadIdx.x == 0) { xst[0] = 0u; xst[1] = 0u; }
    __syncthreads();
    const XcdBarrier xb = xcd_barrier_post((unsigned*)(P.ws + WS_BAR), xst);
    if (__builtin_amdgcn_readfirstlane(threadIdx.x) >= 256) __builtin_amdgcn_s_setprio(1);
    { LAUNDER(Q); phase_w(Q, lds); }
    grid.sync();
#pragma unroll 1
    for (int hb = 0; hb < 2; ++hb) {
        { LAUNDER(Q); phase_n(Q, hb); }
        xcd_barrier(xb);
#pragma unroll 1
        for (int l = 0; l < 2; ++l) {
            { LAUNDER(Q); phase_g1(Q, lds, l); }
            xcd_barrier(xb);
            { LAUNDER(Q); phase_att(Q, lds, hb, l); }
            xcd_barrier(xb);
            { LAUNDER(Q); phase_cmb(Q); }
            xcd_barrier(xb);
            { LAUNDER(Q); phase_g2(Q, lds, l); }
            xcd_barrier(xb);
            { LAUNDER(Q); phase_f(Q, hb, l); }
            if (!(hb == 1 && l == 1)) xcd_barrier(xb);
        }
    }
}

extern "C" void kernel_launch(void* const* d_in, const int* in_sizes, int n_in, void* d_out, int out_size, void* d_ws, size_t ws_size,
                              hipStream_t stream) {
    static int grid_blocks = 0;
    if (!grid_blocks) {
        int dev = 0, cus = 0, per_cu = 0;
        hipGetDevice(&dev);
        hipDeviceGetAttribute(&cus, hipDeviceAttributeMultiprocessorCount, dev);
        hipFuncSetAttribute((const void*)mega, hipFuncAttributeMaxDynamicSharedMemorySize, LDS_BYTES);
        hipOccupancyMaxActiveBlocksPerMultiprocessor(&per_cu, mega, NTHR, LDS_BYTES);
        if (per_cu > 1) per_cu = 1;
        if (per_cu < 1) per_cu = 1;
        grid_blocks = cus * per_cu;
        if (ws_size < WS_END) fprintf(stderr, "kernel_launch: workspace too small: %zu < %zu\n", ws_size, (size_t)WS_END);
    }
    hipMemsetAsync((char*)d_ws + WS_BAR, 0, XCD_BAR_WORDS * 4, stream);
    Params p{};
    p.x = (const float*)d_in[0]; p.c = (const float*)d_in[1]; p.rel = (const float*)d_in[2]; p.w_in = (const float*)d_in[3];
    p.w_out = (const float*)d_in[4]; p.w_ada = (const float*)d_in[5]; p.b_ada = (const float*)d_in[6]; p.g_pre = (const float*)d_in[7];
    p.g_post = (const float*)d_in[8]; p.sinks = (const float*)d_in[9]; p.lq1 = (const float*)d_in[10]; p.lk1 = (const float*)d_in[11];
    p.lq2 = (const float*)d_in[12]; p.lk2 = (const float*)d_in[13]; p.g_sub = (const float*)d_in[14];
    p.out = (float*)d_out; p.ws = (unsigned char*)d_ws;
    void* args[] = {&p};
    hipError_t e = hipLaunchCooperativeKernel((void*)mega, dim3(grid_blocks), dim3(NTHR), args, LDS_BYTES, stream);
    if (e != hipSuccess) fprintf(stderr, "cooperative launch failed: %s (grid %d)\n", hipGetErrorString(e), grid_blocks);
}
```

```cpp
#include <hip/hip_runtime.h>
#include <hip/hip_cooperative_groups.h>
#include <cstdio>
#include <cstdint>
namespace cg = cooperative_groups;

typedef unsigned short u16;
using bf16x8 = __attribute__((ext_vector_type(8))) short;
using s16x4  = __attribute__((ext_vector_type(4))) short;
using f32x16 = __attribute__((ext_vector_type(16))) float;
using f32x4  = __attribute__((ext_vector_type(4))) float;
using u32x4  = __attribute__((ext_vector_type(4))) unsigned;
using u32x2  = __attribute__((ext_vector_type(2))) unsigned;
typedef __bf16 bf2_t __attribute__((ext_vector_type(2)));
typedef float fl2_t __attribute__((ext_vector_type(2)));
typedef short v4i16_t __attribute__((ext_vector_type(4)));
#define LAS __attribute__((address_space(3)))
typedef LAS const char* lptr;

#define DI __device__ __forceinline__
#define MFMA(a, b, c) __builtin_amdgcn_mfma_f32_32x32x16_bf16((a), (b), (c), 0, 0, 0)

constexpr int DM = 1024, SEQ = 8192, PO = 7168, PON = 7040, HT = 16384;
constexpr int NTHR = 512, NWAVE = 8;
constexpr int OFF_AQ = 0, OFF_AK = 768, OFF_AV = 960, OFF_BQ = 1152, OFF_BK = 1920, OFF_BV = 2688,
              OFF_CQ = 3456, OFF_CK = 3968, OFF_CV = 4480, OFF_Z = 4992;
constexpr float LOG2E = 1.4426950408889634f, LN2 = 0.6931471805599453f;
constexpr float SC2 = 0.125f * LOG2E;
constexpr float EPS = 1e-6f;

constexpr size_t WS_CTR = 0;
constexpr size_t WS_MOD = 4096;
constexpr size_t WS_LAM = 110592;
constexpr size_t WS_BAR = 112640;
constexpr size_t WS_TABB = 131072;
constexpr size_t WS_TABC = WS_TABB + 4 * 12 * 384 * 4;
constexpr size_t WS_WIN = 1u << 20;
constexpr size_t WS_WOUT = WS_WIN + (size_t)2 * 7168 * 1024 * 2;
constexpr size_t WS_HH = WS_WOUT + (size_t)2 * 1024 * 2048 * 2;
constexpr size_t WS_Y2 = WS_HH + (size_t)HT * 1024 * 2;
constexpr size_t WS_PBO = WS_Y2 + (size_t)HT * 1024 * 4;
constexpr size_t WS_PBL = WS_PBO + (size_t)3 * HT * 768 * 2;
constexpr size_t WS_PH = WS_PBL + (size_t)3 * HT * 12 * 4;
constexpr size_t WS_END = WS_PH + (size_t)HT * PO * 2;

constexpr int LDS_BYTES = 139904;
constexpr int LDS_CTAB = 131072;
constexpr int LDS_XB = 139776;
constexpr int LDS_SLOT = 139792;

struct Params {
    const float *x, *c, *rel, *w_in, *w_out, *w_ada, *b_ada, *g_pre, *g_post, *sinks, *lq1, *lk1, *lq2, *lk2, *g_sub;
    float* out;
    unsigned char* ws;
};

DI unsigned pk2(float lo, float hi) { fl2_t f = {lo, hi}; bf2_t b = __builtin_convertvector(f, bf2_t); return __builtin_bit_cast(unsigned, b); }
DI float bflo(unsigned u) { return __uint_as_float(u << 16); }
DI float bfhi(unsigned u) { return __uint_as_float(u & 0xffff0000u); }
DI float swap32f(float v) { auto rr = __builtin_amdgcn_permlane32_swap(__float_as_uint(v), __float_as_uint(v), false, false);
    return __uint_as_float(rr[0]) ; }
DI float xhalf_max(float v) { auto rr = __builtin_amdgcn_permlane32_swap(__float_as_uint(v), __float_as_uint(v), false, false);
    return fmaxf(__uint_as_float(rr[0]), __uint_as_float(rr[1])); }
DI float xhalf_sum(float v) { auto rr = __builtin_amdgcn_permlane32_swap(__float_as_uint(v), __float_as_uint(v), false, false);
    return __uint_as_float(rr[0]) + __uint_as_float(rr[1]); }
DI float wave_sum(float v) {
#pragma unroll
    for (int o = 1; o < 64; o <<= 1) v += __shfl_xor(v, o);
    return v;
}
DI int get_tid() { int t = threadIdx.x; asm volatile("" : "+v"(t)); return t; }
DI float silu_f(float z) { return z / (1.f + __expf(-z)); }
DI float afma(float a, float b, float c) { float d; asm("v_fma_f32 %0, %1, %2, %3" : "=v"(d) : "v"(a), "v"(b), "v"(c)); return d; }
DI float aadd(float a, float b) { float d; asm("v_add_f32 %0, %1, %2" : "=v"(d) : "v"(a), "v"(b)); return d; }
DI float amax3(float a, float b, float c) { float d; asm("v_max3_f32 %0, %1, %2, %3" : "=v"(d) : "v"(a), "v"(b), "v"(c)); return d; }
DI float asub(float a, float b) { float d; asm("v_sub_f32 %0, %1, %2" : "=v"(d) : "v"(a), "v"(b)); return d; }
DI s16x4 vtr(lptr p) { return __builtin_bit_cast(s16x4, __builtin_amdgcn_ds_read_tr16_b64_v4i16((LAS v4i16_t*)p)); }

__device__ int rel_bucket_dev(int n) {
    if (n < 0) n = 0;
    if (n < 16) return n;
    float nf = (float)n;
    int large = 16 + (int)(logf(nf / 16.f) / 4.852030263919617f * 16.f);
    return large < 31 ? large : 31;
}

DI void phase_w(const Params& P, char* lds) {
    const int tid = get_tid();
    const int half = tid >> 8, t = tid & 255;
    constexpr int NI_IN = 2 * 16 * 110, NI_OUT = 2 * 32 * 16, NI_MOD = 96;
    u16* win_t = (u16*)(P.ws + WS_WIN);
    u16* wout_t = (u16*)(P.ws + WS_WOUT);
    for (int pr = blockIdx.x; pr < (NI_IN + NI_OUT + NI_MOD) / 2; pr += gridDim.x) {
        const int it = 2 * pr + half;
        if (it < NI_IN + NI_OUT) {
            const float* W; u16* WT; int K, N, kt, nt;
            if (it < NI_IN) { int l = it / 1760, r = it % 1760; K = 1024; N = 7040; W = P.w_in + (size_t)l * 1024 * 7040; WT = win_t + (size_t)l * 7168 * 1024; kt = r / 110; nt = r % 110; }
            else { int r0 = it - NI_IN; int l = r0 / 512, r = r0 % 512; K = 2048; N = 1024; W = P.w_out + (size_t)l * 2048 * 1024; WT = wout_t + (size_t)l * 1024 * 2048; kt = r / 16; nt = r % 16; }
            float* tile = (float*)(lds + half * 16896);
            const int ty = t >> 4, tx = t & 15;
#pragma unroll
            for (int i = 0; i < 4; ++i) {
                int k = ty + 16 * i;
                f32x4 v = *(const f32x4*)(W + (size_t)(kt * 64 + k) * N + nt * 64 + tx * 4);
                tile[k * 65 + tx * 4 + 0] = v.x; tile[k * 65 + tx * 4 + 1] = v.y; tile[k * 65 + tx * 4 + 2] = v.z; tile[k * 65 + tx * 4 + 3] = v.w;
            }
            __syncthreads();
            const int n = t >> 2, kc = t & 3;
            unsigned o[8];
#pragma unroll
            for (int j = 0; j < 8; ++j) o[j] = pk2(tile[(kc * 16 + 2 * j) * 65 + n], tile[(kc * 16 + 2 * j + 1) * 65 + n]);
            u32x4* dst = (u32x4*)(WT + (size_t)(nt * 64 + n) * K + kt * 64 + kc * 16);
            u32x4 a = {o[0], o[1], o[2], o[3]}, b = {o[4], o[5], o[6], o[7]};
            dst[0] = a; dst[1] = b;
            __syncthreads();
        } else {
            const int mi = it - NI_IN - NI_OUT; const int l = mi / 48, cb = mi % 48;
            float* cact = (float*)lds;
            float* red = (float*)(lds + 16384 + half * 4096);
            for (int idx = tid; idx < 4096; idx += NTHR) { float cv = P.c[idx]; cact[idx] = cv / (1.f + expf(-cv)); }
            __syncthreads();
            const int j = t & 63, ks = t >> 6; const int col = cb * 64 + j;
            float a0 = 0.f, a1 = 0.f, a2 = 0.f, a3 = 0.f;
            const float* wp = P.w_ada + (size_t)l * 1024 * 3072 + col;
#pragma unroll 8
            for (int k = ks * 256; k < ks * 256 + 256; ++k) {
                float w = wp[(size_t)k * 3072];
                a0 += cact[k] * w; a1 += cact[1024 + k] * w; a2 += cact[2048 + k] * w; a3 += cact[3072 + k] * w;
            }
            red[(ks * 4 + 0) * 64 + j] = a0; red[(ks * 4 + 1) * 64 + j] = a1; red[(ks * 4 + 2) * 64 + j] = a2; red[(ks * 4 + 3) * 64 + j] = a3;
            __syncthreads();
            {
                const int b = t >> 6;
                float s = red[(0 * 4 + b) * 64 + j] + red[(1 * 4 + b) * 64 + j] + red[(2 * 4 + b) * 64 + j] + red[(3 * 4 + b) * 64 + j];
                s += P.b_ada[l * 3072 + col];
                ((float*)(P.ws + WS_MOD))[(l * 4 + b) * 3072 + col] = s;
            }
            __syncthreads();
        }
    }
    {
        u32x4 z = {0u, 0u, 0u, 0u};
        for (int i = blockIdx.x * NTHR + tid; i < 32768; i += gridDim.x * NTHR) {
            const int l = i >> 14, o = i & 16383;
            *(u32x4*)(win_t + ((size_t)l * 7168 + 7040) * 1024 + (size_t)o * 8) = z;
        }
    }
    if (blockIdx.x == gridDim.x - 1) {
        float* tabB = (float*)(P.ws + WS_TABB);
        float* tabC = (float*)(P.ws + WS_TABC);
        for (int idx = tid; idx < 4 * 12 * 384; idx += NTHR) {
            int type = idx / (12 * 384); int head = (idx / 384) % 12; int ii = idx % 384; int dist = ii - 128;
            int maxd = type == 0 ? 127 : 128; int dscale = type <= 1 ? 1 : (type == 2 ? 4 : 16); int col = type == 0 ? head : 12 + head;
            float val = -INFINITY;
            if (dist >= 0 && dist <= maxd) val = P.rel[rel_bucket_dev(dist * dscale) * 28 + col] * LOG2E;
            tabB[idx] = val;
        }
        for (int idx = tid; idx < 4 * 2112; idx += NTHR) {
            int h = idx / 2112; int ii = idx % 2112; int dist = ii - 64;
            float val = -INFINITY;
            if (dist >= 0) val = P.rel[rel_bucket_dev(dist) * 28 + 24 + h] * LOG2E;
            tabC[idx] = val;
        }
        if (tid < 2) {
            int l = tid; float s1 = 0.f, s2 = 0.f;
            for (int i = 0; i < 64; ++i) { s1 += P.lq1[l * 64 + i] * P.lk1[l * 64 + i]; s2 += P.lq2[l * 64 + i] * P.lk2[l * 64 + i]; }
            float lam_init = 0.8f - 0.6f * expf(-0.3f * (float)l);
            ((float*)(P.ws + WS_LAM))[l] = expf(s1) - expf(s2) + lam_init;
        }
        if (tid < 64) ((unsigned*)(P.ws + WS_CTR))[tid] = 0u;
    }
}

DI void phase_n(const Params& P, int hb) {
    const int tid = get_tid(); const int lane = tid & 63, wid = tid >> 6;
    const float* mod = (const float*)(P.ws + WS_MOD);
    u16* Hh = (u16*)(P.ws + WS_HH);
    for (int row = blockIdx.x * NWAVE + wid; row < HT; row += gridDim.x * NWAVE) {
        const int grow = hb * HT + row; const int b = grow / SEQ;
        const f32x4* xr = (const f32x4*)(P.x + (size_t)grow * DM);
        f32x4 v[4]; float ss = 0.f;
#pragma unroll
        for (int j = 0; j < 4; ++j) { v[j] = xr[lane + 64 * j]; ss += v[j].x * v[j].x + v[j].y * v[j].y + v[j].z * v[j].z + v[j].w * v[j].w; }
        const float rstd = rsqrtf(wave_sum(ss) * (1.f / DM) + EPS);
        const f32x4* g = (const f32x4*)(P.g_pre);
        const f32x4* sh = (const f32x4*)(mod + (0 * 4 + b) * 3072);
        const f32x4* sc = (const f32x4*)(mod + (0 * 4 + b) * 3072 + 1024);
        u32x2* o8 = (u32x2*)(Hh + (size_t)row * DM);
#pragma unroll
        for (int j = 0; j < 4; ++j) {
            const int c4 = lane + 64 * j; f32x4 gg = g[c4], s1 = sc[c4], s0 = sh[c4];
            float h0 = v[j].x * rstd * gg.x * (1.f + s1.x) + s0.x, h1 = v[j].y * rstd * gg.y * (1.f + s1.y) + s0.y;
            float h2 = v[j].z * rstd * gg.z * (1.f + s1.z) + s0.z, h3 = v[j].w * rstd * gg.w * (1.f + s1.w) + s0.w;
            u32x2 o = {pk2(h0, h1), pk2(h2, h3)}; o8[c4] = o;
        }
    }
}

DI void phase_f(const Params& P, int hb, int l) {
    const int tid = get_tid(); const int lane = tid & 63, wid = tid >> 6;
    const float* mod = (const float*)(P.ws + WS_MOD);
    u16* Hh = (u16*)(P.ws + WS_HH);
    const u16* Y2 = (const u16*)(P.ws + WS_Y2);
    const float* xin_base = l == 0 ? P.x : P.out;
    for (int row = blockIdx.x * NWAVE + wid; row < HT; row += gridDim.x * NWAVE) {
        const int grow = hb * HT + row; const int b = grow / SEQ;
        const u32x2* yr = (const u32x2*)(Y2 + (size_t)row * DM);
        const f32x4* xr = (const f32x4*)(xin_base + (size_t)grow * DM);
        f32x4 v[4], xv[4]; float ss = 0.f;
#pragma unroll
        for (int j = 0; j < 4; ++j) { const u32x2 yy = yr[lane + 64 * j]; v[j].x = bflo(yy.x); v[j].y = bfhi(yy.x); v[j].z = bflo(yy.y); v[j].w = bfhi(yy.y);
            xv[j] = xr[lane + 64 * j]; ss += v[j].x * v[j].x + v[j].y * v[j].y + v[j].z * v[j].z + v[j].w * v[j].w; }
        const float rstd = rsqrtf(wave_sum(ss) * (1.f / DM) + EPS);
        const f32x4* g = (const f32x4*)(P.g_post + l * DM);
        const f32x4* gt = (const f32x4*)(mod + (l * 4 + b) * 3072 + 2048);
        f32x4* orow = (f32x4*)(P.out + (size_t)grow * DM);
        float ss2 = 0.f;
#pragma unroll
        for (int j = 0; j < 4; ++j) {
            const int c4 = lane + 64 * j; f32x4 gg = g[c4], ga = gt[c4];
            xv[j].x += ga.x * (v[j].x * rstd * gg.x); xv[j].y += ga.y * (v[j].y * rstd * gg.y);
            xv[j].z += ga.z * (v[j].z * rstd * gg.z); xv[j].w += ga.w * (v[j].w * rstd * gg.w);
            orow[c4] = xv[j];
            ss2 += xv[j].x * xv[j].x + xv[j].y * xv[j].y + xv[j].z * xv[j].z + xv[j].w * xv[j].w;
        }
        if (l == 0) {
            const float rstd2 = rsqrtf(wave_sum(ss2) * (1.f / DM) + EPS);
            const f32x4* g1 = (const f32x4*)(P.g_pre + DM);
            const f32x4* sh = (const f32x4*)(mod + (1 * 4 + b) * 3072);
            const f32x4* sc = (const f32x4*)(mod + (1 * 4 + b) * 3072 + 1024);
            u32x2* o8 = (u32x2*)(Hh + (size_t)row * DM);
#pragma unroll
            for (int j = 0; j < 4; ++j) {
                const int c4 = lane + 64 * j; f32x4 gg = g1[c4], s1 = sc[c4], s0 = sh[c4];
                float h0 = xv[j].x * rstd2 * gg.x * (1.f + s1.x) + s0.x, h1 = xv[j].y * rstd2 * gg.y * (1.f + s1.y) + s0.y;
                float h2 = xv[j].z * rstd2 * gg.z * (1.f + s1.z) + s0.z, h3 = xv[j].w * rstd2 * gg.w * (1.f + s1.w) + s0.w;
                u32x2 o = {pk2(h0, h1), pk2(h2, h3)}; o8[c4] = o;
            }
        }
    }
}

DI void glds16(const void* g, unsigned lds_base) {
    unsigned sv; asm volatile("s_mov_b32 %0, m0\n\ts_mov_b32 m0, %2\n\ts_nop 0\n\tglobal_load_lds_dwordx4 %1, off\n\ts_mov_b32 m0, %0" : "=&s"(sv) : "v"(g), "s"(lds_base) : "memory"); }
namespace pg8 {
constexpr int BM = 256, BK = 64, HALF = 128, HTB = HALF * BK * 2  ;
DI int lds_byte(int r, int c) { const int st = (r >> 4) * 2 + (c >> 5), rr = r & 15, cc = c & 31, ob = rr * 64 + cc * 2; return st * 1024 + (ob ^ (((ob >> 9) & 1) << 5)); }
DI void stage_rc(int b, int& R, int& C) { const int st = b / 1024, sb = b % 1024, swz = sb ^ (((sb >> 9) & 1) << 5); R = (st >> 1) * 16 + swz / 64; C = (st & 1) * 32 + (swz % 64) / 2; }
DI int perm32(int rho) { const int n = rho >> 4, i = rho & 15; return 8 * (i >> 2) + 4 * n + (i & 3); }
struct Unit { int pm, pn; };
DI bool next_unit(int i, int nunits, Unit& u) {
    const int L = i * (int)gridDim.x + (int)blockIdx.x; if (L >= nunits) return false;
    const int i2 = L >> 8, b = L & 255, x = b & 7, j = b >> 3; u.pm = 8 * x + (j & 7); u.pn = 4 * i2 + (j >> 3); return true;
}
template <bool REMAP>
DI void gemm_phase(LAS unsigned char* lds, const u16* A, int lda, const u16* Bt, int K, u16* O, int ldc, int nunits) {
    const int tid = get_tid(), wid = __builtin_amdgcn_readfirstlane(tid >> 6), lane = tid & 63, wr = wid >> 2, wc = wid & 3, fr = lane & 15, fq = lane >> 4;
    const int nt = K / BK;
    unsigned voffA[2], voffB[2];
#pragma unroll
    for (int i = 0; i < 2; ++i) { int R, C; stage_rc(tid * 16 + i * 8192, R, C); const int Rb = (R & ~31) + perm32(R & 31);
        voffA[i] = (unsigned)(R * lda + C) * 2u; voffB[i] = (unsigned)(Rb * K + C) * 2u; }
    const size_t kstep = (size_t)(BK * 2);
    const size_t hstepA = (size_t)HALF * lda * 2, hstepB = (size_t)HALF * K * 2;
    const size_t tstepA = 2 * hstepA, tstepB = 2 * hstepB;
    auto akb = [&](int kt) -> size_t { const int k0 = kt * BK; return (size_t)(REMAP ? (k0 < 768 ? k0 : (k0 < 1536 ? k0 + 384 : k0 + 1920)) : k0) * 2; };
    const unsigned ldsw = (unsigned)wid * 1024u;
    const int aoff = lds_byte(wr * 64 + fr, fq * 8), boff = lds_byte(wc * 32 + fr, fq * 8);
#define PG8_SA(b, h) (((b) * 2 + (h)) * HTB)
#define PG8_SB(b, h) ((4 + (b) * 2 + (h)) * HTB)
#define PG8_STAGE(bufoff, gbase, voff) do { _Pragma("unroll") for (int _i = 0; _i < 2; ++_i) \
        __builtin_amdgcn_global_load_lds((const unsigned*)((const char*)(gbase) + (voff)[_i]), (LAS unsigned*)(lds + (bufoff) + ldsw + _i * 8192), 16, 0, 0); } while (0)
#define PG8_LDA(dst, b, h) do { _Pragma("unroll") for (int m = 0; m < 4; ++m) _Pragma("unroll") for (int k = 0; k < 2; ++k) dst[m][k] = *(const LAS bf16x8*)(lds + PG8_SA(b, h) + aoff + m * 2048 + k * 1024); } while (0)
#define PG8_LDB(dst, b, h) do { _Pragma("unroll") for (int n = 0; n < 2; ++n) _Pragma("unroll") for (int k = 0; k < 2; ++k) dst[n][k] = *(const LAS bf16x8*)(lds + PG8_SB(b, h) + boff + n * 2048 + k * 1024); } while (0)
#define PG8_MMA(ai, bj, At, Bt_) do { __builtin_amdgcn_s_setprio(1); _Pragma("unroll") for (int m = 0; m < 4; ++m) _Pragma("unroll") for (int n = 0; n < 2; ++n) _Pragma("unroll") for (int k = 0; k < 2; ++k) \
        acc[ai][bj][m][n] = __builtin_amdgcn_mfma_f32_16x16x32_bf16(Bt_[n][k], At[m][k], acc[ai][bj][m][n], 0, 0, 0); __builtin_amdgcn_s_setprio(0); } while (0)
#define PG8_WAIT_V(n) asm volatile("s_waitcnt vmcnt(" #n ")" ::: "memory")
#define PG8_WAIT_L(n) asm volatile("s_waitcnt lgkmcnt(" #n ")" ::: "memory")
#define PG8_BAR __builtin_amdgcn_s_barrier()
#define PG8_SCHED __builtin_amdgcn_sched_barrier(0)
    Unit cur, nxt; int ui = 0;
    if (!next_unit(0, nunits, cur)) return;
    f32x4 acc[2][2][4][2];
#pragma unroll
    for (int a = 0; a < 2; ++a)
#pragma unroll
        for (int b = 0; b < 2; ++b)
#pragma unroll
            for (int m = 0; m < 4; ++m)
#pragma unroll
                for (int n = 0; n < 2; ++n) acc[a][b][m][n] = (f32x4){0.f, 0.f, 0.f, 0.f};
    bf16x8 At[4][2], B0[2][2], B1[2][2];
    const char* cA = (const char*)A + (size_t)cur.pm * tstepA; const char* cB = (const char*)Bt + (size_t)cur.pn * tstepB;
    PG8_STAGE(PG8_SB(0, 0), cB, voffB); PG8_STAGE(PG8_SA(0, 0), cA + akb(0), voffA); PG8_STAGE(PG8_SB(0, 1), cB + hstepB, voffB); PG8_STAGE(PG8_SA(0, 1), cA + akb(0) + hstepA, voffA);
    if (wr == 1) PG8_BAR;
    PG8_WAIT_V(4); PG8_BAR;
    PG8_STAGE(PG8_SB(1, 0), cB + kstep, voffB); PG8_STAGE(PG8_SA(1, 0), cA + akb(1), voffA); PG8_STAGE(PG8_SB(1, 1), cB + hstepB + kstep, voffB);
    PG8_WAIT_V(6); PG8_BAR;
    for (;;) {
        const bool has_next = next_unit(ui + 1, nunits, nxt);
        const char* nA = has_next ? (const char*)A + (size_t)nxt.pm * tstepA : cA; const char* nB = has_next ? (const char*)Bt + (size_t)nxt.pn * tstepB : cB;
        for (int t = 0; t < nt; t += 2) {
            const bool last = (t == nt - 2);
            const char* a1 = cA + akb(t + 1);
            const char* a2 = last ? nA + akb(0) : cA + akb(t + 2); const char* b2 = last ? nB : cB + (size_t)(t + 2) * kstep;
            const char* a3 = last ? nA + akb(1) : cA + akb(t + 3); const char* b3 = b2 + kstep;
            PG8_LDB(B0, 0, 0); PG8_SCHED; PG8_LDA(At, 0, 0); PG8_STAGE(PG8_SA(1, 1), a1 + hstepA, voffA);
            PG8_WAIT_L(8); PG8_BAR; PG8_WAIT_L(0); PG8_MMA(0, 0, At, B0); PG8_BAR; PG8_SCHED;
            PG8_LDB(B1, 0, 1); PG8_STAGE(PG8_SB(0, 0), b2, voffB);
            PG8_BAR; PG8_WAIT_L(0); PG8_MMA(0, 1, At, B1); PG8_BAR;
            PG8_LDA(At, 0, 1); PG8_STAGE(PG8_SA(0, 0), a2, voffA);
            PG8_BAR; PG8_WAIT_L(0); PG8_MMA(1, 0, At, B0); PG8_BAR; PG8_SCHED;
            PG8_STAGE(PG8_SB(0, 1), b2 + hstepB, voffB);
            PG8_WAIT_V(6); PG8_BAR; PG8_MMA(1, 1, At, B1); PG8_BAR;
            PG8_LDB(B0, 1, 0); PG8_SCHED; PG8_LDA(At, 1, 0); PG8_STAGE(PG8_SA(0, 1), a2 + hstepA, voffA);
            PG8_WAIT_L(8); PG8_BAR; PG8_WAIT_L(0); PG8_MMA(0, 0, At, B0); PG8_BAR; PG8_SCHED;
            PG8_LDB(B1, 1, 1); PG8_STAGE(PG8_SB(1, 0), b3, voffB);
            PG8_BAR; PG8_WAIT_L(0); PG8_MMA(0, 1, At, B1); PG8_BAR;
            PG8_LDA(At, 1, 1); PG8_STAGE(PG8_SA(1, 0), a3, voffA);
            PG8_BAR; PG8_WAIT_L(0); PG8_MMA(1, 0, At, B0); PG8_BAR; PG8_SCHED;
            PG8_STAGE(PG8_SB(1, 1), b3 + hstepB, voffB);
            PG8_WAIT_V(6); PG8_BAR; PG8_MMA(1, 1, At, B1); PG8_BAR;
        }
        {
            const int row0 = cur.pm * BM + wr * 64 + fr, col0 = cur.pn * BM + wc * 32 + 8 * fq;
#pragma unroll
            for (int ai = 0; ai < 2; ++ai)
#pragma unroll
                for (int m = 0; m < 4; ++m) { u16* rowp = O + (size_t)(row0 + ai * HALF + m * 16) * ldc + col0;
#pragma unroll
                    for (int bj = 0; bj < 2; ++bj) { const f32x4 v0 = acc[ai][bj][m][0], v1 = acc[ai][bj][m][1];
                        u32x4 w = {pk2(v0[0], v0[1]), pk2(v0[2], v0[3]), pk2(v1[0], v1[1]), pk2(v1[2], v1[3])};
                        *(u32x4*)(rowp + bj * HALF) = w; } }
        }
        if (!has_next) break;
#pragma unroll
        for (int a = 0; a < 2; ++a)
#pragma unroll
            for (int b = 0; b < 2; ++b)
#pragma unroll
                for (int m = 0; m < 4; ++m)
#pragma unroll
                    for (int n = 0; n < 2; ++n) acc[a][b][m][n] = (f32x4){0.f, 0.f, 0.f, 0.f};
        cur = nxt; cA = nA; cB = nB; ++ui;
    }
    PG8_WAIT_V(0);
    if (wr == 0) PG8_BAR;
    PG8_BAR;
#undef PG8_SA
#undef PG8_SB
#undef PG8_STAGE
#undef PG8_LDA
#undef PG8_LDB
#undef PG8_MMA
#undef PG8_WAIT_V
#undef PG8_WAIT_L
#undef PG8_BAR
#undef PG8_SCHED
}
}

DI void phase_g1(const Params& P, char* lds, int l) {
    const u16* A = (const u16*)(P.ws + WS_HH);
    const u16* Bt = (const u16*)(P.ws + WS_WIN) + (size_t)l * 7168 * 1024;
    pg8::gemm_phase<false>((LAS unsigned char*)lds, A, DM, Bt, 1024, (u16*)(P.ws + WS_PH), PO, 64 * 28);
}
DI void phase_g2(const Params& P, char* lds, int l) {
    const u16* A = (const u16*)(P.ws + WS_PH);
    const u16* Bt = (const u16*)(P.ws + WS_WOUT) + (size_t)l * 1024 * 2048;
    pg8::gemm_phase<true>((LAS unsigned char*)lds, A, PO, Bt, 2048, (u16*)(P.ws + WS_Y2), DM, 64 * 4);
}

constexpr int GP = 144;
#define ROWMAX32(mx)                                                                                                                   \
    {   float a_ = amax3(p0[0], p0[1], p1[0]), b_ = amax3(p0[2], p0[3], p1[1]);                                                       \
        a_ = amax3(a_, p1[2], p1[3]);                                                                                                 \
        _Pragma("unroll") for (int i = 4; i < 16; i += 4) { a_ = amax3(a_, p0[i], p0[i + 1]); b_ = amax3(b_, p0[i + 2], p0[i + 3]); a_ = amax3(a_, p1[i], p1[i + 1]); b_ = amax3(b_, p1[i + 2], p1[i + 3]); } \
        mx = fmaxf(a_, b_); }
#define ATTN_TAIL(DVT, VADDR)                                                                                                         \
    bf16x8 vf[2][DVT];                                                                                                                \
    _Pragma("unroll") for (int dt = 0; dt < DVT; ++dt) { s16x4 lo = vtr(VADDR(0, dt, 0)), hi = vtr(VADDR(0, dt, 1));                  \
        vf[0][dt] = __builtin_shufflevector(lo, hi, 0, 1, 2, 3, 4, 5, 6, 7); }                                                        \
    __builtin_amdgcn_sched_barrier(0);                                                                                                \
    float mn, ls; const float m_old = m; const float sc2v = SC2;                                                                      \
    if (far) {          \
        float mx;                                                                                                                     \
        __builtin_amdgcn_sched_barrier(0);                                                                                            \
        asm volatile("s_nop 7\n\ts_nop 7\n\ts_nop 3" ::: "memory");             \
        __builtin_amdgcn_sched_barrier(0);                                                                                            \
        ROWMAX32(mx)                                                                                                                  \
        mx = fmaf(xhalf_max(mx), SC2, cfar);                                                                                          \
        mn = fmaxf(m, mx);                                                                                                            \
        const float cb = cfar - mn;                                                                                                   \
        __builtin_amdgcn_sched_barrier(0);                                                                                            \
        _Pragma("unroll") for (int i = 0; i < 16; ++i) { p0[i] = afma(p0[i], sc2v, cb); p1[i] = afma(p1[i], sc2v, cb); }              \
    } else {                                                                                                                          \
        float bb0[16], bb1[16];                                                                                                       \
        _Pragma("unroll") for (int i = 0; i < 16; ++i) { const int c = (i & 3) + 8 * (i >> 2); bb0[i] = tb[63 - c]; bb1[i] = tb[31 - c]; } \
        __builtin_amdgcn_sched_barrier(0);                                                                                            \
        asm volatile("s_nop 7\n\ts_nop 7\n\ts_nop 3" ::: "memory");             \
        __builtin_amdgcn_sched_barrier(0);                                                                                            \
        _Pragma("unroll") for (int i = 0; i < 16; ++i) { p0[i] = afma(p0[i], sc2v, bb0[i]); p1[i] = afma(p1[i], sc2v, bb1[i]); }      \
        float mx;                                                                                                                     \
        ROWMAX32(mx)                                                                                                                  \
        mx = xhalf_max(mx);                                                                                                           \
        mn = fmaxf(m, mx);                                                                                                            \
        _Pragma("unroll") for (int i = 0; i < 16; ++i) { p0[i] = asub(p0[i], mn); p1[i] = asub(p1[i], mn); }                          \
    }                                                                                                                                 \
    _Pragma("unroll") for (int i = 0; i < 16; ++i) { p0[i] = __builtin_amdgcn_exp2f(p0[i]); p1[i] = __builtin_amdgcn_exp2f(p1[i]); }  \
    __builtin_amdgcn_sched_barrier(0);                                                                                                \
    asm volatile("s_nop 1" ::: "memory");                                                  \
    {   float t8[8];                                                                                                                  \
        _Pragma("unroll") for (int i = 0; i < 8; ++i) t8[i] = aadd(aadd(p0[i], p1[i]), aadd(p0[i + 8], p1[i + 8]));                   \
        ls = aadd(aadd(aadd(t8[0], t8[1]), aadd(t8[2], t8[3])), aadd(aadd(t8[4], t8[5]), aadd(t8[6], t8[7])));                        \
    }                                                                                                                                 \
    m = mn;                                                                                                                           \
    if (__builtin_amdgcn_ballot_w64(mn != m_old) != 0ull) {           \
        const float alpha = __builtin_amdgcn_exp2f(m_old - mn);                                                                       \
        l *= alpha;                                                                                                                   \
        _Pragma("unroll") for (int dt = 0; dt < DVT; ++dt)                                                                            \
            _Pragma("unroll") for (int i = 0; i < 16; ++i) O[dt][i] *= alpha;                                                         \
    }                                                                                                                                 \
    l += ls;                                                                                                                          \
    _Pragma("unroll") for (int g = 0; g < 4; ++g) {                                                                                   \
        if (g < 3) {                                                                                                                  \
            _Pragma("unroll") for (int dt = 0; dt < DVT; ++dt) { s16x4 lo = vtr(VADDR(g + 1, dt, 0)), hi = vtr(VADDR(g + 1, dt, 1));  \
                vf[(g + 1) & 1][dt] = __builtin_shufflevector(lo, hi, 0, 1, 2, 3, 4, 5, 6, 7); }                                      \
        }                                                                                                                             \
        u32x4 pw; const int s2 = g & 1;                                                                                               \
        if (g < 2) { pw[0] = pk2(p0[8 * s2 + 0], p0[8 * s2 + 1]); pw[1] = pk2(p0[8 * s2 + 2], p0[8 * s2 + 3]); pw[2] = pk2(p0[8 * s2 + 4], p0[8 * s2 + 5]); pw[3] = pk2(p0[8 * s2 + 6], p0[8 * s2 + 7]); } \
        else { pw[0] = pk2(p1[8 * s2 + 0], p1[8 * s2 + 1]); pw[1] = pk2(p1[8 * s2 + 2], p1[8 * s2 + 3]); pw[2] = pk2(p1[8 * s2 + 4], p1[8 * s2 + 5]); pw[3] = pk2(p1[8 * s2 + 6], p1[8 * s2 + 7]); }        \
        const bf16x8 pf = __builtin_bit_cast(bf16x8, pw);                                                                             \
        _Pragma("unroll") for (int dt = 0; dt < DVT; ++dt) O[dt] = MFMA(vf[g & 1][dt], pf, O[dt]);                                    \
                                                    \
        _Pragma("unroll") for (int dt = 0; dt < DVT; ++dt) { __builtin_amdgcn_sched_group_barrier(0x008, 1, 0); __builtin_amdgcn_sched_group_barrier(0x100, 2, 0); } \
        __builtin_amdgcn_sched_barrier(0);                                                                                            \
    }

template <int DVT>
DI void attn_step(lptr sKw, int kpitch, lptr sV, int vpitch, const bf16x8 (&qf)[4], float& m, float& l, f32x16 (&O)[DVT],
                  const LAS float* tb, bool far, float cfar, int lane) {
    const int r = lane & 31, h = lane >> 5;
    f32x16 p0, p1;
#pragma unroll
    for (int i = 0; i < 16; ++i) { p0[i] = 0.f; p1[i] = 0.f; }
    bf16x8 kf[8];
#pragma unroll
    for (int s = 0; s < 4; ++s) {
        kf[2 * s] = *(const LAS bf16x8*)(sKw + r * kpitch + (16 * s + 8 * h) * 2);
        kf[2 * s + 1] = *(const LAS bf16x8*)(sKw + (32 + r) * kpitch + (16 * s + 8 * h) * 2);
    }
    __builtin_amdgcn_sched_barrier(0);
#pragma unroll
    for (int s = 0; s < 4; ++s) { p0 = MFMA(kf[2 * s], qf[s], p0); p1 = MFMA(kf[2 * s + 1], qf[s], p1); }
    const int i16 = lane & 15, q = i16 >> 2, pp = i16 & 3, blk = (lane >> 4) & 1;
    lptr vb = sV + (4 * h + q) * vpitch + (16 * blk + 4 * pp) * 2;
#define VADDR_PAD(g, dt, hi) (vb + (16 * (g) + 8 * (hi)) * vpitch + (dt) * 64)
    ATTN_TAIL(DVT, VADDR_PAD)
#undef VADDR_PAD
}

DI void band_item(const Params& P, char* lds_blk, int layer, int bp) {
    const int tid0 = get_tid(); const int half = tid0 >> 8, tid = tid0 & 255, lane = tid & 63, w = tid >> 6, r = lane & 31, h = lane >> 5;
    char* lds = lds_blk + half * 40960;
    const int type = bp / 768, rem = bp % 768; const int bl = rem / 384, head = 2 * ((rem % 384) / 64) + half, blk = rem % 64;
    const int dil = type <= 1 ? 1 : (type == 2 ? 4 : 16);
    const int nper = 64 / dil; const int residue = blk / nper, nb = blk % nper;
    u16* Ph = (u16*)(P.ws + WS_PH);
    const size_t rs = (size_t)dil * PO;
    const size_t base_row = (size_t)bl * SEQ + residue + (size_t)dil * 128 * nb;
    int qcol, kcol, vcol;
    if (type == 0) { qcol = OFF_AQ + head * 64; kcol = OFF_AK + (head >> 2) * 64; vcol = OFF_AV + (head >> 2) * 64; }
    else { qcol = OFF_BQ + head * 64; kcol = OFF_BK + head * 64; vcol = OFF_BV + head * 64; }
    const u16* qp = Ph + base_row * PO + qcol;
    const u16* kp = Ph + base_row * PO + kcol;
    const u16* vp = Ph + base_row * PO + vcol;
    float* btab = (float*)(lds + 4 * 64 * GP);
    const float* tabg = (const float*)(P.ws + WS_TABB) + (type * 12 + head) * 384;
    for (int i = tid; i < 384; i += 256) btab[i] = tabg[i];
    bf16x8 qf[4];
#pragma unroll
    for (int s = 0; s < 4; ++s) qf[s] = *(const bf16x8*)(qp + (size_t)(32 * w + r) * rs + 16 * s + 8 * h);
    float m = -1e30f, l = 0.f;
    if (type == 0) { m = P.sinks[layer * 12 + head] * LOG2E; l = (h == 0) ? 1.f : 0.f; }
    f32x16 O[2];
#pragma unroll
    for (int dt = 0; dt < 2; ++dt)
#pragma unroll
        for (int i = 0; i < 16; ++i) O[dt][i] = 0.f;
    const int maxd = type == 0 ? 127 : 128;
    const int qpos = 128 + 32 * w + r;
    const int kt0 = (nb == 0 ? 2 : 0);
    u32x4 rk[2], rv[2];
    const int srow = tid >> 3, sch = tid & 7;
    auto gload = [&](int kt) {
#pragma unroll
        for (int j = 0; j < 2; ++j) {
            const ptrdiff_t ro = ((ptrdiff_t)(64 * kt + srow + 32 * j) - 128) * (ptrdiff_t)rs + sch * 8;
            rk[j] = *(const u32x4*)(kp + ro); rv[j] = *(const u32x4*)(vp + ro);
        }
    };
    auto lstore = [&](int b) {
        char* sK = lds + b * (2 * 64 * GP); char* sV = sK + 64 * GP;
#pragma unroll
        for (int j = 0; j < 2; ++j) { *(u32x4*)(sK + (srow + 32 * j) * GP + sch * 16) = rk[j]; *(u32x4*)(sV + (srow + 32 * j) * GP + sch * 16) = rv[j]; }
    };
    gload(kt0); lstore(0);
    for (int kt = kt0; kt < 4; ++kt) {
        if (kt + 1 < 4) gload(kt + 1);
        __syncthreads();
        const int b = (kt - kt0) & 1;
        const bool active = (64 * kt <= 128 + 32 * w + 31) && (64 * kt + 63 >= 128 + 32 * w - maxd);
        if (active) {
            const LAS float* tb = (const LAS float*)btab + (qpos - 64 * kt - 4 * h + 128 - 63);
            lptr sK = (lptr)lds + b * (2 * 64 * GP);
            attn_step<2>(sK, GP, sK + 64 * GP, GP, qf, m, l, O, tb, false, 0.f, lane);
        }
        if (kt + 1 < 4) lstore(b ^ 1);
    }
    __syncthreads();
    const float ltot = xhalf_sum(l);
    const float inv = 1.f / ltot;
    constexpr int OP = 272;
    char* sO = lds + w * (32 * OP);
#pragma unroll
    for (int dt = 0; dt < 2; ++dt)
#pragma unroll
        for (int g = 0; g < 4; ++g) {
            f32x4 o4 = {O[dt][4 * g + 0] * inv, O[dt][4 * g + 1] * inv, O[dt][4 * g + 2] * inv, O[dt][4 * g + 3] * inv};
            *(f32x4*)(sO + r * OP + (32 * dt + 8 * g + 4 * h) * 4) = o4;
        }
    if (type != 0 && h == 0) ((float*)(P.ws + WS_PBL))[((size_t)(type - 1) * HT + base_row + (size_t)(32 * w + r) * dil) * 12 + head] = (m + __builtin_amdgcn_logf(ltot)) * LN2;
    const int ch = lane & 7;
#pragma unroll
    for (int j = 0; j < 4; ++j) {
        const int rl = (lane >> 3) + 8 * j;
        const f32x4 a = *(const f32x4*)(sO + rl * OP + ch * 32), b = *(const f32x4*)(sO + rl * OP + ch * 32 + 16);
        const size_t orow = base_row + (size_t)(32 * w + rl) * dil;
        if (type == 0) {
            const u32x4 zz = *(const u32x4*)(Ph + orow * PO + OFF_Z + head * 64 + ch * 8);
            u32x4 o = {pk2(a.x * silu_f(bflo(zz.x)), a.y * silu_f(bfhi(zz.x))), pk2(a.z * silu_f(bflo(zz.y)), a.w * silu_f(bfhi(zz.y))),
                       pk2(b.x * silu_f(bflo(zz.z)), b.y * silu_f(bfhi(zz.z))), pk2(b.z * silu_f(bflo(zz.w)), b.w * silu_f(bfhi(zz.w)))};
            *(u32x4*)(Ph + orow * PO + OFF_AQ + head * 64 + ch * 8) = o;
        } else {
            u32x4 o = {pk2(a.x, a.y), pk2(a.z, a.w), pk2(b.x, b.y), pk2(b.z, b.w)};
            *(u32x4*)((u16*)(P.ws + WS_PBO) + ((size_t)(type - 1) * HT + orow) * 768 + head * 64 + ch * 8) = o;
        }
    }
}

template <typename F>
DI void diff_step(lptr sK, lptr sV, int kx0, int vl0, const bf16x8 (&qf)[4], float& m, float& l, f32x16 (&O)[4],
                  const LAS float* tb, bool far, float cfar, int lane, F&& mid) {
    const int r = lane & 31;
    f32x16 p0, p1;
#pragma unroll
    for (int i = 0; i < 16; ++i) { p0[i] = 0.f; p1[i] = 0.f; }
    lptr kr = sK + r * 256;
    bf16x8 kf[8];
#pragma unroll
    for (int s = 0; s < 4; ++s) {
        const int co = (kx0 ^ (2 * s)) * 16;
        kf[2 * s] = *(const LAS bf16x8*)(kr + co);
        kf[2 * s + 1] = *(const LAS bf16x8*)(kr + 8192 + co);
    }
    __builtin_amdgcn_sched_barrier(0);
    mid();
    __builtin_amdgcn_sched_barrier(0);
#pragma unroll
    for (int s = 0; s < 4; ++s) { p0 = MFMA(kf[2 * s], qf[s], p0); p1 = MFMA(kf[2 * s + 1], qf[s], p1); }
#define VADDR_SWZ(g, dt, hi) (sV + (vl0 ^ (((dt) << 6) | ((hi) << 5))) + (16 * (g) + 8 * (hi)) * 256)
    ATTN_TAIL(4, VADDR_SWZ)
#undef VADDR_SWZ
}

DI void diff_item(const Params& P, char* lds, int layer, int pair, int qt, int& tab_head) {
    const int tid = get_tid(), lane = tid & 63, w = tid >> 6, r = lane & 31, hh = lane >> 5;
    const int bl = pair >> 2, head = pair & 3;
    const int mp = w >> 2, qs = w & 3;
    u16* Ph = (u16*)(P.ws + WS_PH);
    u16* base = Ph + (size_t)bl * SEQ * PO;
    const int q0 = 128 * qt;
    const int qpos = q0 + 32 * qs + r;
    float* ctab = (float*)(lds + LDS_CTAB);
    const float* tabg = (const float*)(P.ws + WS_TABC) + head * 2112;
    if (tab_head != head) { for (int i = tid; i < 2112; i += NTHR) ctab[i] = tabg[i]; tab_head = head; }
    const float cfar = tabg[2111];
    const unsigned lds0 = (unsigned)(uintptr_t)lds;
    int goff[2];
#pragma unroll
    for (int i = 0; i < 2; ++i) goff[i] = (8 * w + 4 * i + (lane >> 4)) * PO + (((lane & 15) ^ (((lane >> 4) << 2) | ((2 * w + i) & 3))) * 8);
    const u16* kg = base + head * 128 + OFF_CK;
    const u16* vg = base + head * 128 + OFF_CV;
    auto issue = [&](int kt, int buf) {
        const size_t to = (size_t)(64 * kt) * PO;
#pragma unroll
        for (int i = 0; i < 2; ++i) {
            glds16(kg + to + goff[i], (unsigned)__builtin_amdgcn_readfirstlane(lds0 + buf * 32768 + (2 * w + i) * 1024));
            glds16(vg + to + goff[i], (unsigned)__builtin_amdgcn_readfirstlane(lds0 + buf * 32768 + 16384 + (2 * w + i) * 1024));
        }
    };
    issue(0, 0);
    bf16x8 qf[4];
#pragma unroll
    for (int s = 0; s < 4; ++s) qf[s] = *(const bf16x8*)(base + (size_t)qpos * PO + OFF_CQ + head * 128 + mp * 64 + 16 * s + 8 * hh);
    float m = -1e30f, l = 0.f;
    f32x16 O[4];
#pragma unroll
    for (int dt = 0; dt < 4; ++dt)
#pragma unroll
        for (int i = 0; i < 16; ++i) O[dt][i] = 0.f;
    const int sig_r = ((r & 3) << 2) | ((r >> 2) & 3);
    const int kx0 = (8 * mp + hh) ^ sig_r;
    const int i16 = lane & 15, q = i16 >> 2, pp = i16 & 3, blk = (lane >> 4) & 1;
    const int vl0 = (4 * hh + q) * 256 + (16 * ((q << 2) | (blk << 1) | ((pp >> 1) ^ hh)) + 8 * (pp & 1));
    const int nkt = 2 * qt + 2;
    for (int kt = 0; kt < nkt; ++kt) {
        asm volatile("s_waitcnt vmcnt(0)" ::: "memory");
        __syncthreads();
        auto mid = [&]() { if (kt + 1 < nkt) issue(kt + 1, (kt + 1) & 1); };
        if (64 * kt <= q0 + 32 * qs + 31) {
            const bool far = (q0 + 32 * qs) - (64 * kt + 63) >= 1536;
            const LAS float* tb = (const LAS float*)ctab + (qpos - 64 * kt - 4 * hh + 64 - 63);
            lptr bufp = (lptr)lds + (kt & 1) * 32768;
            diff_step(bufp, bufp + 16384, kx0, vl0, qf, m, l, O, tb, far, cfar, lane, mid);
        } else mid();
    }
    __syncthreads();
    const float inv = 1.f / xhalf_sum(l);
    float* cmb = (float*)lds;
    if (mp == 1) {
#pragma unroll
        for (int dt = 0; dt < 4; ++dt)
#pragma unroll
            for (int i = 0; i < 16; ++i) cmb[(qs * 128 + 32 * dt + (i & 3) + 8 * (i >> 2) + 4 * hh) * 32 + r] = O[dt][i] * inv;
    }
    __syncthreads();
    if (mp == 0) {
        const float lam = ((const float*)(P.ws + WS_LAM))[layer];
        const float lam_init = 0.8f - 0.6f * expf(-0.3f * (float)layer);
        float ss = 0.f;
#pragma unroll
        for (int dt = 0; dt < 4; ++dt)
#pragma unroll
            for (int i = 0; i < 16; ++i) {
                float o = O[dt][i] * inv - lam * cmb[(qs * 128 + 32 * dt + (i & 3) + 8 * (i >> 2) + 4 * hh) * 32 + r];
                O[dt][i] = o; ss += o * o;
            }
        ss = xhalf_sum(ss);
        const float rstd = rsqrtf(ss * (1.f / 128.f) + EPS) * (1.f - lam_init);
        const float* gs = P.g_sub + layer * 128;
        u16* orow = base + (size_t)qpos * PO;
#pragma unroll
        for (int dt = 0; dt < 4; ++dt)
#pragma unroll
            for (int g = 0; g < 4; ++g) {
                const int d = 32 * dt + 8 * g + 4 * hh;
                u32x2 zz = *(const u32x2*)(orow + OFF_Z + 1536 + head * 128 + d);
                f32x4 gg = *(const f32x4*)(gs + d);
                float y0 = O[dt][4 * g + 0] * rstd * gg.x * silu_f(bflo(zz.x)), y1 = O[dt][4 * g + 1] * rstd * gg.y * silu_f(bfhi(zz.x));
                float y2 = O[dt][4 * g + 2] * rstd * gg.z * silu_f(bflo(zz.y)), y3 = O[dt][4 * g + 3] * rstd * gg.w * silu_f(bfhi(zz.y));
                u32x2 o = {pk2(y0, y1), pk2(y2, y3)};
                *(u32x2*)(orow + OFF_CQ + head * 128 + d) = o;
            }
    }
    __syncthreads();
}

DI void phase_att(const Params& P, char* lds, int hb, int layer) {
    unsigned* ctr = (unsigned*)(P.ws + WS_CTR) + (hb * 2 + layer) * 8;
    LAS int* slot = (LAS int*)(lds + LDS_SLOT);
    const int tid = get_tid();
    constexpr int NQ = 64 + 384;
    int tab_head = -1;
    for (int dq = 0; dq < 8; ++dq) {
        const int qx = (blockIdx.x + dq) & 7;
        while (true) {
            if (tid == 0) *slot = (int)atomicAdd(&ctr[qx], 1u);
            __syncthreads();
            const int qi = *slot;
            __syncthreads();
            if (qi >= NQ) break;
            if (qi < 64) diff_item(P, lds, layer, qx, 63 - qi, tab_head);
            else band_item(P, lds, layer, qx * 384 + (qi - 64));
        }
    }
}

DI void phase_cmb(const Params& P) {
    u16* Ph = (u16*)(P.ws + WS_PH);
    const u16* pbo = (const u16*)(P.ws + WS_PBO);
    const float* pbl = (const float*)(P.ws + WS_PBL);
    const int tid = get_tid();
    for (int idx = blockIdx.x * NTHR + tid; idx < HT * 96; idx += gridDim.x * NTHR) {
        const int row = idx / 96, c8 = idx % 96; const int head = c8 >> 3;
        float l0 = pbl[((size_t)0 * HT + row) * 12 + head], l1 = pbl[((size_t)1 * HT + row) * 12 + head], l2 = pbl[((size_t)2 * HT + row) * 12 + head];
        float mx = fmaxf(l0, fmaxf(l1, l2));
        float w0 = __expf(l0 - mx), w1 = __expf(l1 - mx), w2 = __expf(l2 - mx);
        const float inv = 1.f / (w0 + w1 + w2); w0 *= inv; w1 *= inv; w2 *= inv;
        u32x4 a = *(const u32x4*)(pbo + ((size_t)0 * HT + row) * 768 + c8 * 8);
        u32x4 b = *(const u32x4*)(pbo + ((size_t)1 * HT + row) * 768 + c8 * 8);
        u32x4 c = *(const u32x4*)(pbo + ((size_t)2 * HT + row) * 768 + c8 * 8);
        u32x4 z = *(const u32x4*)(Ph + (size_t)row * PO + OFF_Z + 768 + c8 * 8);
        u32x4 o;
#pragma unroll
        for (int j = 0; j < 4; ++j) {
            float lo = (w0 * bflo(a[j]) + w1 * bflo(b[j]) + w2 * bflo(c[j])) * silu_f(bflo(z[j]));
            float hi = (w0 * bfhi(a[j]) + w1 * bfhi(b[j]) + w2 * bfhi(c[j])) * silu_f(bfhi(z[j]));
            o[j] = pk2(lo, hi);
        }
        *(u32x4*)(Ph + (size_t)row * PO + OFF_BQ + c8 * 8) = o;
    }
}


#define XB_TMO      128
#define XB_XCNT(j)  (256  + 64 * (j))
#define XB_XSUB(j)  (1280 + 64 * (j))
#define XB_XGEN(j)  (2304 + 64 * (j))
#define XB_TOP      3328
#define XB_TOPGEN   3392
#define XCD_BAR_WORDS 3456
#define XB_SPIN_CAP (1u << 22)
DI unsigned xb_ld(unsigned* p)              { return __hip_atomic_load(p, __ATOMIC_RELAXED, __HIP_MEMORY_SCOPE_AGENT); }
DI unsigned xb_add(unsigned* p, unsigned v) { return __hip_atomic_fetch_add(p, v, __ATOMIC_RELAXED, __HIP_MEMORY_SCOPE_AGENT); }
DI unsigned xb_xcc_id() { return (unsigned)__builtin_amdgcn_s_getreg((3 << 11) | 20) & 0xFu; }
#define XB_SPIN(cond, bar) do { unsigned _sp = 0; while (cond) { __builtin_amdgcn_s_sleep(1); \
    if ((++_sp & 255u) == 0u) { if (xb_ld(&(bar)[XB_TMO])) break; if (_sp > XB_SPIN_CAP) { atomicAdd(&(bar)[XB_TMO], 1u); break; } } } } while (0)
struct XcdBarrier { unsigned* bar; unsigned x; volatile LAS unsigned* st; };
DI XcdBarrier xcd_barrier_post(unsigned* bar, volatile LAS unsigned* st) {
    XcdBarrier b; b.bar = bar; b.x = xb_xcc_id(); b.st = st;
    if (threadIdx.x == 0) (void)xb_add(&bar[XB_XCNT(b.x)], 1u);
    return b;
}
DI void xcd_barrier_complete(unsigned* bar, unsigned x, unsigned& nloc, unsigned& nx) {
    const unsigned G = gridDim.x * gridDim.y * gridDim.z;
    unsigned sum, cnt, mine, sp = 0u;
    for (;;) {
        sum = 0u; cnt = 0u; mine = 0u;
#pragma unroll
        for (unsigned j = 0; j < 16; ++j) { const unsigned c = xb_ld(&bar[XB_XCNT(j)]); sum += c; cnt += (c > 0u) ? 1u : 0u; mine = (j == x) ? c : mine; }
        if (sum == G) break;
        __builtin_amdgcn_s_sleep(1);
        if ((++sp & 255u) == 0u) { if (xb_ld(&bar[XB_TMO])) break; if (sp > XB_SPIN_CAP) { atomicAdd(&bar[XB_TMO], 1u); break; } }
    }
    nloc = mine > 0u ? mine : 1u; nx = cnt > 0u ? cnt : 1u;
}
DI void xcd_barrier(const XcdBarrier& b) {
    asm volatile("s_waitcnt vmcnt(0)" ::: "memory");
    __syncthreads();
    if (threadIdx.x == 0) {
        unsigned* bar = b.bar;
        __builtin_amdgcn_s_waitcnt(0);
        unsigned nloc = b.st[0], nx = b.st[1];
        if (nloc == 0u) { xcd_barrier_complete(bar, b.x, nloc, nx); b.st[0] = nloc; b.st[1] = nx; }
        const unsigned old = xb_add(&bar[XB_XSUB(b.x)], 1u);
        const unsigned gen = old / nloc;
        if (old + 1u == (gen + 1u) * nloc) {
            __builtin_amdgcn_fence(__ATOMIC_RELEASE, "agent");
            asm volatile("s_waitcnt vmcnt(0)" ::: "memory");
            const unsigned og = xb_add(&bar[XB_TOP], 1u);
            const unsigned tg = og / nx;
            if (og + 1u == (tg + 1u) * nx) xb_add(&bar[XB_TOPGEN], 1u);
            else XB_SPIN(xb_ld(&bar[XB_TOPGEN]) == tg, bar);
            __builtin_amdgcn_fence(__ATOMIC_ACQUIRE, "agent");
            xb_add(&bar[XB_XGEN(b.x)], 1u);
            asm volatile("s_waitcnt vmcnt(0)" ::: "memory");
        } else {
            XB_SPIN(xb_ld(&bar[XB_XGEN(b.x)]) == gen, bar);
            __builtin_amdgcn_fence(__ATOMIC_ACQUIRE, "agent");
            asm volatile("s_waitcnt vmcnt(0)" ::: "memory");
        }
    }
    __syncthreads();
}

#define LAUNDER(Q) Params Q = P; asm volatile("" : "+s"(Q.ws), "+s"(Q.out), "+s"(Q.x), "+s"(Q.rel), "+s"(Q.g_sub), "+s"(Q.sinks))
__global__ void __launch_bounds__(512, 1) mega(Params P) {
    extern __shared__ __attribute__((aligned(16))) char lds[];
    cg::grid_group grid = cg::this_grid();
    volatile LAS unsigned* xst = (volatile LAS unsigned*)(lds + LDS_XB);
    if (threadIdx.x == 0) { xst[0] = 0u; xst[1] = 0u; }
    __syncthreads();
    const XcdBarrier xb = xcd_barrier_post((unsigned*)(P.ws + WS_BAR), xst);
    if (__builtin_amdgcn_readfirstlane(threadIdx.x) >= 256) __builtin_amdgcn_s_setprio(1);
    { LAUNDER(Q); phase_w(Q, lds); }
    grid.sync();
#pragma unroll 1
    for (int hb = 0; hb < 2; ++hb) {
        { LAUNDER(Q); phase_n(Q, hb); }
        xcd_barrier(xb);
#pragma unroll 1
        for (int l = 0; l < 2; ++l) {
            { LAUNDER(Q); phase_g1(Q, lds, l); }
            xcd_barrier(xb);
            { LAUNDER(Q); phase_att(Q, lds, hb, l); }
            xcd_barrier(xb);
            { LAUNDER(Q); phase_cmb(Q); }
            xcd_barrier(xb);
            { LAUNDER(Q); phase_g2(Q, lds, l); }
            xcd_barrier(xb);
            { LAUNDER(Q); phase_f(Q, hb, l); }
            if (!(hb == 1 && l == 1)) xcd_barrier(xb);
        }
    }
}

extern "C" void kernel_launch(void* const* d_in, const int* in_sizes, int n_in, void* d_out, int out_size, void* d_ws, size_t ws_size,
                              hipStream_t stream) {
    static int grid_blocks = 0;
    if (!grid_blocks) {
        int dev = 0, cus = 0, per_cu = 0;
        hipGetDevice(&dev);
        hipDeviceGetAttribute(&cus, hipDeviceAttributeMultiprocessorCount, dev);
        hipFuncSetAttribute((const void*)mega, hipFuncAttributeMaxDynamicSharedMemorySize, LDS_BYTES);
        hipOccupancyMaxActiveBlocksPerMultiprocessor(&per_cu, mega, NTHR, LDS_BYTES);
        if (per_cu > 1) per_cu = 1;
        if (per_cu < 1) per_cu = 1;
        grid_blocks = cus * per_cu;
        if (ws_size < WS_END) fprintf(stderr, "kernel_launch: workspace too small: %zu < %zu\n", ws_size, (size_t)WS_END);
    }
    hipMemsetAsync((char*)d_ws + WS_BAR, 0, XCD_BAR_WORDS * 4, stream);
    Params p{};
    p.x = (const float*)d_in[0]; p.c = (const float*)d_in[1]; p.rel = (const float*)d_in[2]; p.w_in = (const float*)d_in[3];
    p.w_out = (const float*)d_in[4]; p.w_ada = (const float*)d_in[5]; p.b_ada = (const float*)d_in[6]; p.g_pre = (const float*)d_in[7];
    p.g_post = (const float*)d_in[8]; p.sinks = (const float*)d_in[9]; p.lq1 = (const float*)d_in[10]; p.lk1 = (const float*)d_in[11];
    p.lq2 = (const float*)d_in[12]; p.lk2 = (const float*)d_in[13]; p.g_sub = (const float*)d_in[14];
    p.out = (float*)d_out; p.ws = (unsigned char*)d_ws;
    void* args[] = {&p};
    hipError_t e = hipLaunchCooperativeKernel((void*)mega, dim3(grid_blocks), dim3(NTHR), args, LDS_BYTES, stream);
    if (e != hipSuccess) fprintf(stderr, "cooperative launch failed: %s (grid %d)\n", hipGetErrorString(e), grid_blocks);
}
```
